# Optimizing an MI355X kernel written in HIP

```python
import jax, jax.numpy as jnp
from jax import lax
import numpy as np

D_MODEL = 1024
BATCH = 16
SEQ = 4096
DEPTH = 1

CTX_LEN = 256
GRID_W = 64
RET_W = D_MODEL // 2
RET_HEADS = 4
RET_HEAD_DIM = RET_W // RET_HEADS
FOURIER_W = D_MODEL - RET_W
FOURIER_GROUPS = 4
FOURIER_GROUP_DIM = FOURIER_W // FOURIER_GROUPS
MIX_W = RET_W + FOURIER_W
IN_W = 4 * RET_W + FOURIER_W
D_FF = ((8 * D_MODEL // 3 + 127) // 128) * 128
CONV_WIDTH = 3
CHUNK = 128
ROPE_BASE = 10000.0
NORM_EPS = 1e-6
N_MOD = 6

kernel_name = "hybrid_retention_fourier_convffn_dit"


def rms_norm(x, g):
    xf = x.astype(jnp.float32)
    xf = xf * lax.rsqrt(jnp.mean(xf * xf, axis=-1, keepdims=True) + NORM_EPS)
    return xf.astype(x.dtype) * g


def modulate(h, shift, scale):
    return h * (1 + scale) + shift


def adaln(cond, w, b):
    return jnp.split(jax.nn.silu(cond) @ w + b, N_MOD, axis=-1)


def split_heads(t):
    bsz, length, _ = t.shape
    return t.reshape(bsz, length, RET_HEADS, RET_HEAD_DIM).transpose(0, 2, 1, 3).astype(jnp.float32)


def axial_rope(length):
    t = jnp.arange(length)
    row = (t // GRID_W).astype(jnp.float32)
    col = (t % GRID_W).astype(jnp.float32)
    n_freq = RET_HEAD_DIM // 4
    freqs = ROPE_BASE ** (-jnp.arange(n_freq, dtype=jnp.float32) / n_freq)
    ang = jnp.concatenate([row[:, None] * freqs, col[:, None] * freqs], axis=-1)
    return jnp.cos(ang), jnp.sin(ang)


def apply_rope(t, cos, sin):
    half = RET_HEAD_DIM // 2
    t1, t2 = t[..., :half], t[..., half:]
    return jnp.concatenate([t1 * cos - t2 * sin, t1 * sin + t2 * cos], axis=-1)


def retention_scan(q, k, v, log_gamma, init_state, strict):
    bsz, heads, length, dk = q.shape
    dv = v.shape[-1]
    n_chunks = length // CHUNK
    pos = jnp.arange(CHUNK, dtype=jnp.float32)
    diff = pos[:, None] - pos[None, :]
    mask = diff > 0 if strict else diff >= 0
    dmask = jnp.where(mask[None], jnp.exp(jnp.where(mask, diff, 0.0)[None] * log_gamma[:, None, None]), 0.0)
    qc = q.reshape(bsz, heads, n_chunks, CHUNK, dk)
    kc = k.reshape(bsz, heads, n_chunks, CHUNK, dk)
    vc = v.reshape(bsz, heads, n_chunks, CHUNK, dv)
    scores = jnp.einsum('bhncd,bhnmd->bhncm', qc, kc) * dmask[:, None]
    intra = jnp.einsum('bhncm,bhnme->bhnce', scores, vc)
    zeta = jnp.exp((CHUNK - 1 - pos)[None, :] * log_gamma[:, None])
    xi = jnp.exp((pos + 1)[None, :] * log_gamma[:, None])
    kv = jnp.einsum('bhnmd,bhnme->nbhde', kc * zeta[None, :, None, :, None], vc)
    chunk_decay = jnp.exp(CHUNK * log_gamma)[None, :, None, None]

    def step(state, kv_i):
        return state * chunk_decay + kv_i, state

    _, prev = lax.scan(step, init_state, kv)
    cross = jnp.einsum('bhncd,nbhde->bhnce', qc * xi[None, :, None, :, None], prev)
    return (intra + cross).reshape(bsz, heads, length, dv)


def context_states(h_ctx, w_in, lg_f, lg_b):
    kv = h_ctx @ w_in[:, RET_W:3 * RET_W]
    k, v = jnp.split(kv, 2, axis=-1)
    k = split_heads(k) * RET_HEAD_DIM ** -0.5
    v = split_heads(v)
    length = k.shape[2]
    m = jnp.arange(length, dtype=jnp.float32)
    w_f = jnp.exp((length - 1 - m)[None, :] * lg_f[:, None])
    w_b = jnp.exp(m[None, :] * lg_b[:, None])
    s_f = jnp.einsum('bhld,hl,bhle->bhde', k, w_f, v)
    s_b = jnp.einsum('bhld,hl,bhle->bhde', k, w_b, v)
    return s_f, s_b


def fourier_mix(f):
    bsz, length, _ = f.shape
    fg = f.reshape(bsz, length, FOURIER_GROUPS, FOURIER_GROUP_DIM).astype(jnp.float32)
    out = jnp.fft.fft2(fg, axes=(1, 3), norm="ortho").real
    return out.reshape(bsz, length, FOURIER_W).astype(f.dtype)


def token_mixer(h, w_in, w_out, lg_f, lg_b, init_f, init_b, rope):
    proj = h @ w_in
    q, k, v, g, f = jnp.split(proj, [RET_W, 2 * RET_W, 3 * RET_W, 4 * RET_W], axis=-1)
    q = split_heads(q)
    k = split_heads(k) * RET_HEAD_DIM ** -0.5
    v = split_heads(v)
    if rope is not None:
        q = apply_rope(q, *rope)
        k = apply_rope(k, *rope)
    o_f = retention_scan(q, k, v, lg_f, init_f, strict=False)
    flip = lambda t: jnp.flip(t, axis=2)
    o_b = flip(retention_scan(flip(q), flip(k), flip(v), lg_b, init_b, strict=True))
    o = o_f + o_b
    o = o * lax.rsqrt(jnp.mean(o * o, axis=-1, keepdims=True) + NORM_EPS)
    bsz, length = h.shape[0], h.shape[1]
    o = o.transpose(0, 2, 1, 3).reshape(bsz, length, RET_W).astype(h.dtype)
    ret = o * jax.nn.silu(g)
    return jnp.concatenate([ret, fourier_mix(f)], axis=-1) @ w_out


def conv_ffn(h, w_up, conv_w, conv_b, w_down, rows):
    bsz, length, _ = h.shape
    u = (h @ w_up).reshape(bsz, rows, length // rows, 2 * D_FF)
    up = jnp.pad(u, ((0, 0), (0, 0), (1, 1), (0, 0)))
    u = up[:, :, :-2] * conv_w[0] + up[:, :, 1:-1] * conv_w[1] + up[:, :, 2:] * conv_w[2] + conv_b
    a, b = jnp.split(u.reshape(bsz, length, 2 * D_FF), 2, axis=-1)
    return (jax.nn.silu(a) * b) @ w_down


def setup_inputs(seed: int = 0) -> dict:
    key = jax.random.key(seed)
    ks = jax.random.split(key, 20)
    nrm = lambda k, shape, s: jax.random.normal(k, shape, jnp.float32) * s
    base = 1.0 - 2.0 ** (-5.0 - jnp.arange(RET_HEADS, dtype=jnp.float32))
    logit = jnp.log(base / (1.0 - base))
    return {
        "x": nrm(ks[0], (BATCH, SEQ, D_MODEL), 1.0),
        "c": nrm(ks[1], (BATCH, D_MODEL), 1.0),
        "ctx": nrm(ks[2], (BATCH, CTX_LEN, D_MODEL), 1.0),
        "c_ctx": nrm(ks[3], (D_MODEL,), 1.0),
        "w_ada": nrm(ks[4], (DEPTH, D_MODEL, N_MOD * D_MODEL), D_MODEL ** -0.5),
        "b_ada": nrm(ks[5], (DEPTH, N_MOD * D_MODEL), 0.02),
        "g_mix_pre": 1.0 + nrm(ks[6], (DEPTH, D_MODEL), 0.05),
        "g_mix_post": 1.0 + nrm(ks[7], (DEPTH, D_MODEL), 0.05),
        "g_ffn_pre": 1.0 + nrm(ks[8], (DEPTH, D_MODEL), 0.05),
        "g_ffn_post": 1.0 + nrm(ks[9], (DEPTH, D_MODEL), 0.05),
        "w_in": nrm(ks[10], (DEPTH, D_MODEL, IN_W), D_MODEL ** -0.5),
        "ret_decay_fwd": logit[None] + nrm(ks[11], (DEPTH, RET_HEADS), 0.1),
        "ret_decay_bwd": logit[None] + nrm(ks[12], (DEPTH, RET_HEADS), 0.1),
        "w_out": nrm(ks[13], (DEPTH, MIX_W, D_MODEL), MIX_W ** -0.5),
        "w_up": nrm(ks[14], (DEPTH, D_MODEL, 2 * D_FF), D_MODEL ** -0.5),
        "conv_w": nrm(ks[15], (DEPTH, CONV_WIDTH, 2 * D_FF), CONV_WIDTH ** -0.5),
        "conv_b": nrm(ks[16], (DEPTH, 2 * D_FF), 0.02),
        "w_down": nrm(ks[17], (DEPTH, D_FF, D_MODEL), D_FF ** -0.5),
    }


def reference(x, c, ctx, c_ctx, w_ada, b_ada, g_mix_pre, g_mix_post, g_ffn_pre, g_ffn_post,
              w_in, ret_decay_fwd, ret_decay_bwd, w_out, w_up, conv_w, conv_b, w_down):
    seq_len = x.shape[1]
    rows = seq_len // GRID_W
    rope = axial_rope(seq_len)
    ctx_s = ctx
    for layer in range(DEPTH):
        lg_f = jax.nn.log_sigmoid(ret_decay_fwd[layer].astype(jnp.float32))
        lg_b = jax.nn.log_sigmoid(ret_decay_bwd[layer].astype(jnp.float32))
        sh_a, sc_a, gt_a, sh_f, sc_f, gt_f = [m[:, None, :] for m in adaln(c, w_ada[layer], b_ada[layer])]
        csh_a, csc_a, cgt_a, csh_f, csc_f, cgt_f = adaln(c_ctx, w_ada[layer], b_ada[layer])
        h_ctx = modulate(rms_norm(ctx_s, g_mix_pre[layer]), csh_a, csc_a)
        s_f, s_b = context_states(h_ctx, w_in[layer], lg_f, lg_b)
        h_lat = modulate(rms_norm(x, g_mix_pre[layer]), sh_a, sc_a)
        mix = token_mixer(h_lat, w_in[layer], w_out[layer], lg_f, lg_b, s_f, s_b, rope)
        x = x + gt_a * rms_norm(mix, g_mix_post[layer])
        h_ffn = modulate(rms_norm(x, g_ffn_pre[layer]), sh_f, sc_f)
        ffn = conv_ffn(h_ffn, w_up[layer], conv_w[layer], conv_b[layer], w_down[layer], rows)
        x = x + gt_f * rms_norm(ffn, g_ffn_post[layer])
        if layer + 1 < DEPTH:
            zero = jnp.zeros_like(s_f)
            mix_c = token_mixer(h_ctx, w_in[layer], w_out[layer], lg_f, lg_b, zero, zero, None)
            ctx_s = ctx_s + cgt_a * rms_norm(mix_c, g_mix_post[layer])
            h_cffn = modulate(rms_norm(ctx_s, g_ffn_pre[layer]), csh_f, csc_f)
            ffn_c = conv_ffn(h_cffn, w_up[layer], conv_w[layer], conv_b[layer], w_down[layer], 1)
            ctx_s = ctx_s + cgt_f * rms_norm(ffn_c, g_ffn_post[layer])
    return x
```

```cpp
#include <hip/hip_runtime.h>
#include <cstdio>
#include <cstdint>
namespace pg8 {
#define PG8_LAS __attribute__((address_space(3)))
typedef unsigned short bf16_t;
typedef short bf16x8 __attribute__((ext_vector_type(8)));
typedef float f32x4 __attribute__((ext_vector_type(4)));
typedef unsigned u32x4 __attribute__((ext_vector_type(4)));
constexpr int BM = 256, BK = 64, HALF = 128, HTB = HALF * BK * 2  , STAGE_BYTES = 8 * HTB, NXCD = 8, WGM = 8;

__host__ __device__ __forceinline__ int lds_byte(int r, int c) { const int st = (r >> 4) * 2 + (c >> 5), rr = r & 15, cc = c & 31, ob = rr * 64 + cc * 2; return st * 1024 + (ob ^ (((ob >> 9) & 1) << 5)); }
__host__ __device__ __forceinline__ void stage_rc(int b, int& R, int& C) { const int st = b / 1024, sb = b % 1024, swz = sb ^ (((sb >> 9) & 1) << 5); R = (st >> 1) * 16 + swz / 64; C = (st & 1) * 32 + (swz % 64) / 2; }
__host__ __device__ __forceinline__ int perm32(int rho) { const int n = rho >> 4, i = rho & 15; return 8 * (i >> 2) + 4 * n + (i & 3); }

struct Unit { int pm, pn; };
struct Gemm { const bf16_t* A; const bf16_t* Bt; int M, N, K; };

struct StaticOrder {
    int nM, nN, nwg, G, c, wgm;
    __host__ __device__ void init(int M, int N, int G_, int c_, int wgm_ = 4) { nM = M / BM; nN = N / BM; nwg = nM * nN; G = G_; c = c_; wgm = wgm_; }
    __host__ __device__ bool next(int i, Unit& u) const {
        const long L = (long)i * G + c; if (c < 0 || L >= nwg) return false;
        int wgid = (int)L; { const int q = nwg / NXCD, r = nwg % NXCD, xcd = wgid % NXCD, off = wgid / NXCD; wgid = (xcd < r ? xcd * (q + 1) : r * (q + 1) + (xcd - r) * q) + off; }
        const int nig = wgm * nN, gid = wgid / nig, fm = gid * wgm, gsz = (nM - fm) < wgm ? (nM - fm) : wgm;
        u.pm = fm + ((wgid % nig) % gsz); u.pn = (wgid % nig) / gsz; return true;
    }
    __device__ __forceinline__ void a_ready(const Unit&) const {}
    __device__ __forceinline__ void done(const Unit&) const {}
};

__device__ __forceinline__ unsigned cvt_pk_bf16(float lo, float hi) { unsigned r; asm volatile("v_cvt_pk_bf16_f32 %0, %1, %2" : "=v"(r) : "v"(lo), "v"(hi)); return r; }
struct EpiF32 {
    static constexpr bool PERM = false, AFTER_DRAIN = false, PERMA = false, HAS_PREFETCH = false;
    float* C; int ldc;
    __device__ __forceinline__ void operator()(const f32x4 (&acc)[2][2][4][2], const Unit& u, int wr, int wc, int fr, int fq) const {
        const int row0 = u.pm * BM + wr * 64 + fr, col0 = u.pn * BM + wc * 32 + 4 * fq;
#pragma unroll
        for (int ai = 0; ai < 2; ++ai)
#pragma unroll
            for (int m = 0; m < 4; ++m) { float* rowp = C + (size_t)(row0 + ai * HALF + m * 16) * ldc + col0;
#pragma unroll
                for (int bj = 0; bj < 2; ++bj)
#pragma unroll
                    for (int n = 0; n < 2; ++n) *(f32x4*)(rowp + bj * HALF + n * 16) = acc[ai][bj][m][n]; }
    }
};
struct EpiBf16 {
    static constexpr bool PERM = true, AFTER_DRAIN = false, PERMA = false, HAS_PREFETCH = false;
    bf16_t* O; int ldc;
    __device__ __forceinline__ void operator()(const f32x4 (&acc)[2][2][4][2], const Unit& u, int wr, int wc, int fr, int fq) const {
        const int row0 = u.pm * BM + wr * 64 + fr; const int col0 = u.pn * BM + wc * 32 + 8 * fq;
#pragma unroll
        for (int ai = 0; ai < 2; ++ai)
#pragma unroll
            for (int m = 0; m < 4; ++m) { bf16_t* rowp = O + (size_t)(row0 + ai * HALF + m * 16) * ldc + col0;
#pragma unroll
                for (int bj = 0; bj < 2; ++bj) { const f32x4 v0 = acc[ai][bj][m][0], v1 = acc[ai][bj][m][1];
                    u32x4 w; w.x = cvt_pk_bf16(v0[0], v0[1]); w.y = cvt_pk_bf16(v0[2], v0[3]); w.z = cvt_pk_bf16(v1[0], v1[1]); w.w = cvt_pk_bf16(v1[2], v1[3]);
                    *(u32x4*)(rowp + bj * HALF) = w; } }
    }
};

struct EpiInProj {
    static constexpr bool PERM = true, AFTER_DRAIN = false, PERMA = false, HAS_PREFETCH = false;
    bf16_t* O; int mode;
    __device__ __forceinline__ void store8(bf16_t* p, f32x4 v0, f32x4 v1) const {
        u32x4 w; w.x = cvt_pk_bf16(v0[0], v0[1]); w.y = cvt_pk_bf16(v0[2], v0[3]); w.z = cvt_pk_bf16(v1[0], v1[1]); w.w = cvt_pk_bf16(v1[2], v1[3]); *(u32x4*)p = w; }
    __device__ __forceinline__ void operator()(const f32x4 (&acc)[2][2][4][2], const Unit& u, int wr, int wc, int fr, int fq) const {
        const float KS = 0.08838834764831845f;
        constexpr size_t NHc = 4, SEQc = 4096, DHc = 128, LCc = 256, QKVG_T = (size_t)16 * NHc * SEQc * DHc;
        size_t base, bjstep; int pitch;
        if (mode == 0) {
            if (u.pn < 8) { base = (size_t)(u.pn >> 1) * QKVG_T + (((size_t)(u.pm >> 4) * NHc + 2 * (u.pn & 1)) * SEQc + (size_t)(u.pm & 15) * BM) * DHc; bjstep = SEQc * DHc; pitch = (int)DHc; }
            else { base = 4 * QKVG_T + (((((size_t)(u.pm >> 4) * 4 + 2 * (u.pn - 8)) * 8 + 2 * wc + (fq >> 1)) * SEQc + (size_t)(u.pm & 15) * BM) * 16 + 8 * (fq & 1)) - (size_t)(wc * 32 + 8 * fq);
                   bjstep = (size_t)8 * SEQc * 16; pitch = 16; }
        } else { base = (size_t)(u.pn >> 1) * (16 * NHc * LCc * DHc) + (((size_t)u.pm * NHc + 2 * (u.pn & 1)) * LCc) * DHc; bjstep = LCc * DHc; pitch = (int)DHc; }
        bf16_t* Ob = O + base + wc * 32 + 8 * fq;
        const int rl0 = wr * 64 + fr;
        if (mode == 0 && u.pn < 4) {
            int fqo = fq; asm volatile("" : "+v"(fqo));
            f32x4 rv;
#pragma unroll
            for (int j = 0; j < 4; ++j) rv[j] = exp2f(-(float)(16 * (wc & 1) + 4 * fqo + j) * (13.287712379549449f / 32.f)) * 0.15915494309189535f;
            const float ks = (u.pn >= 2) ? KS : 1.f;
            if (wc < 2) {
#pragma unroll
                for (int ai = 0; ai < 2; ++ai) { const float pos = (float)((4 * u.pm + 2 * ai + wr) & 63); f32x4 cs, sn;
#pragma unroll
                    for (int j = 0; j < 4; ++j) { const float a = pos * rv[j]; cs[j] = __builtin_amdgcn_cosf(a) * ks; sn[j] = __builtin_amdgcn_sinf(a) * ks; }
#pragma unroll
                    for (int m = 0; m < 4; ++m) { bf16_t* rowp = Ob + (size_t)(rl0 + ai * HALF + m * 16) * pitch;
#pragma unroll
                        for (int bj = 0; bj < 2; ++bj) { const f32x4 t1 = acc[ai][bj][m][0], t2 = acc[ai][bj][m][1]; store8(rowp + bj * bjstep, t1 * cs - t2 * sn, t1 * sn + t2 * cs); } }
                    asm volatile("" ::: "memory"); }
            } else {
#pragma unroll
                for (int m = 0; m < 4; ++m) { const float pos = (float)(16 * m + fr); f32x4 cs, sn;
#pragma unroll
                    for (int j = 0; j < 4; ++j) { const float a = pos * rv[j]; cs[j] = __builtin_amdgcn_cosf(a) * ks; sn[j] = __builtin_amdgcn_sinf(a) * ks; }
#pragma unroll
                    for (int ai = 0; ai < 2; ++ai) { bf16_t* rowp = Ob + (size_t)(rl0 + ai * HALF + m * 16) * pitch;
#pragma unroll
                        for (int bj = 0; bj < 2; ++bj) { const f32x4 t1 = acc[ai][bj][m][0], t2 = acc[ai][bj][m][1]; store8(rowp + bj * bjstep, t1 * cs - t2 * sn, t1 * sn + t2 * cs); } }
                    asm volatile("" ::: "memory"); }
            }
        } else {
            const float sc = (mode == 1 && u.pn < 2) ? KS : 1.f;
#pragma unroll
            for (int ai = 0; ai < 2; ++ai)
#pragma unroll
                for (int m = 0; m < 4; ++m) { bf16_t* rowp = Ob + (size_t)(rl0 + ai * HALF + m * 16) * pitch;
#pragma unroll
                    for (int bj = 0; bj < 2; ++bj) store8(rowp + bj * bjstep, acc[ai][bj][m][0] * sc, acc[ai][bj][m][1] * sc); }
        }
    }
};
__device__ __forceinline__ f32x4 dpp_shr1(f32x4 v) { f32x4 r;
#pragma unroll
    for (int j = 0; j < 4; ++j) { const float x = v[j]; r[j] = __int_as_float(__builtin_amdgcn_update_dpp(0, __float_as_int(x), 0x111, 0xf, 0xf, true)); }
    return r; }
__device__ __forceinline__ f32x4 dpp_shl1(f32x4 v) { f32x4 r;
#pragma unroll
    for (int j = 0; j < 4; ++j) { const float x = v[j]; r[j] = __int_as_float(__builtin_amdgcn_update_dpp(0, __float_as_int(x), 0x101, 0xf, 0xf, true)); }
    return r; }
struct EpiUp {
    static constexpr bool PERM = true, AFTER_DRAIN = false, PERMA = true, HAS_PREFETCH = true;
    bf16_t* O; const float* cw; const float* cb;
    typedef float f32x2 __attribute__((ext_vector_type(2)));
    typedef unsigned u32x2 __attribute__((ext_vector_type(2)));
    static constexpr int CONV_LDS = STAGE_BYTES;
    __device__ __forceinline__ void prefetch(PG8_LAS unsigned char* lds, const Unit& u, int wid, int lane, int ui) const {
        if (wid < 4) { const int q = wid * 64 + lane, vec = q >> 5, part = q & 31; constexpr int NUPc = 5632, DFFc = 2816;
            const float* src = ((vec & 3) == 3 ? cb : cw + (vec & 3) * NUPc) + (vec >> 2) * DFFc + u.pn * HALF + part * 4;
            __builtin_amdgcn_global_load_lds((const unsigned*)src, (PG8_LAS unsigned*)(lds + CONV_LDS + (ui & 1) * 4096 + wid * 1024), 16, 0, 0); }
    }
    static __device__ __forceinline__ f32x2 fma2(f32x2 a, f32x2 b, f32x2 c) { return __builtin_elementwise_fma(a, b, c); }
    __device__ __forceinline__ void run(const f32x4 (&acc)[2][2][4][2], const Unit& u, int wr, int wc, int fr, int fq, PG8_LAS unsigned char* lds, int ui) const {
        constexpr int DFFc = 2816;
        const float SA = -1.4426950408889634f, SB = -0.6931471805599453f;
        u32x2 keep[2][4];
#pragma unroll
        for (int n = 0; n < 2; ++n) {
            const PG8_LAS f32x4* cv = (const PG8_LAS f32x4*)(lds + CONV_LDS + (ui & 1) * 4096 + (wc * 32 + 8 * fq + 4 * n) * 4);
            const f32x4 wa0 = cv[0] * SA, wa1 = cv[32] * SA, wa2 = cv[64] * SA, ba = cv[96] * SA;
            const f32x4 wb0 = cv[128] * SB, wb1 = cv[160] * SB, wb2 = cv[192] * SB, bb = cv[224] * SB;
#pragma unroll
            for (int ai = 0; ai < 2; ++ai) {
                bf16_t* rowp = O + (size_t)(u.pm * BM + ai * HALF + wr * 64 + 4 * fr) * DFFc + (u.pn * HALF + wc * 32 + 8 * fq);
                const f32x4 pa = dpp_shr1(acc[ai][0][3][n]), pb = dpp_shr1(acc[ai][1][3][n]), na = dpp_shl1(acc[ai][0][0][n]), nb = dpp_shl1(acc[ai][1][0][n]);
#pragma unroll
                for (int m = 0; m < 4; ++m) {
                    const f32x4 ap = (m == 0) ? pa : acc[ai][0][m == 0 ? 0 : m - 1][n], bp = (m == 0) ? pb : acc[ai][1][m == 0 ? 0 : m - 1][n];
                    const f32x4 an = (m == 3) ? na : acc[ai][0][m == 3 ? 3 : m + 1][n], bn = (m == 3) ? nb : acc[ai][1][m == 3 ? 3 : m + 1][n];
                    const f32x4 ac = acc[ai][0][m][n], bc = acc[ai][1][m][n];
                    f32x2 alo = fma2(wa1.lo, ac.lo, ba.lo), ahi = fma2(wa1.hi, ac.hi, ba.hi), blo = fma2(wb1.lo, bc.lo, bb.lo), bhi = fma2(wb1.hi, bc.hi, bb.hi);
                    alo = fma2(wa0.lo, ap.lo, alo); ahi = fma2(wa0.hi, ap.hi, ahi); blo = fma2(wb0.lo, bp.lo, blo); bhi = fma2(wb0.hi, bp.hi, bhi);
                    alo = fma2(wa2.lo, an.lo, alo); ahi = fma2(wa2.hi, an.hi, ahi); blo = fma2(wb2.lo, bn.lo, blo); bhi = fma2(wb2.hi, bn.hi, bhi);
                    f32x2 elo, ehi; elo.x = __builtin_amdgcn_exp2f(alo.x); elo.y = __builtin_amdgcn_exp2f(alo.y); ehi.x = __builtin_amdgcn_exp2f(ahi.x); ehi.y = __builtin_amdgcn_exp2f(ahi.y);
                    elo = elo + 1.f; ehi = ehi + 1.f;
                    f32x2 rlo, rhi; rlo.x = __builtin_amdgcn_rcpf(elo.x); rlo.y = __builtin_amdgcn_rcpf(elo.y); rhi.x = __builtin_amdgcn_rcpf(ehi.x); rhi.y = __builtin_amdgcn_rcpf(ehi.y);
                    const f32x2 olo = (alo * blo) * rlo, ohi = (ahi * bhi) * rhi;
                    u32x2 w; w.x = cvt_pk_bf16(olo.x, olo.y); w.y = cvt_pk_bf16(ohi.x, ohi.y);
                    if (n == 0) keep[ai][m] = w;
                    else { u32x4 w4; w4.x = keep[ai][m].x; w4.y = keep[ai][m].y; w4.z = w.x; w4.w = w.y; *(u32x4*)(rowp + (size_t)m * DFFc) = w4; }
                }
                asm volatile("" ::: "memory");
            }
        }
    }
};
template <class Epi, class Sched, bool ALIGN_EPI = false, bool SP2 = false>
__device__ __forceinline__ void gemm_phase(PG8_LAS unsigned char* lds, const Gemm g, const Sched& S, const Epi& E) {
    int tid_o = threadIdx.x; asm volatile("" : "+v"(tid_o));
    const int tid = tid_o, wid = __builtin_amdgcn_readfirstlane(tid >> 6), lane = tid & 63, wr = wid >> 2, wc = wid & 3, fr = lane & 15, fq = lane >> 4;
    const int K = g.K, nt = K / BK;
    unsigned voffA[2], voffB[2];
#pragma unroll
    for (int i = 0; i < 2; ++i) { int R, C; stage_rc(tid * 16 + i * 8192, R, C); const int Rb = Epi::PERM ? ((R & ~31) + perm32(R & 31)) : R;
        const int Ra = Epi::PERMA ? ((R & ~63) | ((R & 15) << 2) | ((R >> 4) & 3)) : R;
        voffA[i] = (unsigned)(Ra * K + C) * 2u; voffB[i] = (unsigned)(Rb * K + C) * 2u; }
    const size_t kstep = (size_t)(BK * 2);
    const size_t hstep = (size_t)HALF * K * 2;
    const size_t tstep = 2 * hstep;
    const unsigned ldsw = (unsigned)wid * 1024u;
    const int aoff = lds_byte(wr * 64 + fr, fq * 8), boff = lds_byte(wc * 32 + fr, fq * 8);
#define PG8_SA(b, h) (((b) * 2 + (h)) * HTB)
#define PG8_SB(b, h) ((4 + (b) * 2 + (h)) * HTB)
#define PG8_STAGE(bufoff, gbase, voff) do { _Pragma("unroll") for (int _i = 0; _i < 2; ++_i) \
        __builtin_amdgcn_global_load_lds((const unsigned*)((const char*)(gbase) + (voff)[_i]), (PG8_LAS unsigned*)(lds + (bufoff) + ldsw + _i * 8192), 16, 0, 0); } while (0)
#define PG8_LDA(dst, b, h) do { _Pragma("unroll") for (int m = 0; m < 4; ++m) _Pragma("unroll") for (int k = 0; k < 2; ++k) dst[m][k] = *(const PG8_LAS bf16x8*)(lds + PG8_SA(b, h) + aoff + m * 2048 + k * 1024); } while (0)
#define PG8_LDB(dst, b, h) do { _Pragma("unroll") for (int n = 0; n < 2; ++n) _Pragma("unroll") for (int k = 0; k < 2; ++k) dst[n][k] = *(const PG8_LAS bf16x8*)(lds + PG8_SB(b, h) + boff + n * 2048 + k * 1024); } while (0)
#define PG8_MMA(ai, bj, At, Bt) do { __builtin_amdgcn_s_setprio(1); _Pragma("unroll") for (int m = 0; m < 4; ++m) _Pragma("unroll") for (int n = 0; n < 2; ++n) _Pragma("unroll") for (int k = 0; k < 2; ++k) \
        acc[ai][bj][m][n] = __builtin_amdgcn_mfma_f32_16x16x32_bf16(Bt[n][k], At[m][k], acc[ai][bj][m][n], 0, 0, 0); __builtin_amdgcn_s_setprio(0); } while (0)
#define PG8_WAIT_V(n) asm volatile("s_waitcnt vmcnt(" #n ")" ::: "memory")
#define PG8_WAIT_L(n) asm volatile("s_waitcnt lgkmcnt(" #n ")" ::: "memory")
#define PG8_BAR __builtin_amdgcn_s_barrier()
#define PG8_SCHED __builtin_amdgcn_sched_barrier(0)
    Unit cur, nxt; int ui = 0;
    if (!S.next(0, cur)) return;
    f32x4 acc[2][2][4][2];
#pragma unroll
    for (int a = 0; a < 2; ++a)
#pragma unroll
        for (int b = 0; b < 2; ++b)
#pragma unroll
            for (int m = 0; m < 4; ++m)
#pragma unroll
                for (int n = 0; n < 2; ++n) acc[a][b][m][n] = (f32x4){0.f, 0.f, 0.f, 0.f};
    bf16x8 At[4][2], B0[2][2], B1[2][2];
    const char* cA = (const char*)g.A + (size_t)cur.pm * tstep; const char* cB = (const char*)g.Bt + (size_t)cur.pn * tstep;
    S.a_ready(cur);
    if constexpr (Epi::HAS_PREFETCH) E.prefetch(lds, cur, wid, lane, ui);
    if constexpr (SP2) {
        PG8_STAGE(PG8_SB(0, 0), cB, voffB); PG8_STAGE(PG8_SB(0, 1), cB + hstep, voffB); PG8_STAGE(PG8_SA(0, 0), cA, voffA); PG8_STAGE(PG8_SA(0, 1), cA + hstep, voffA);
        if (wr == 1) PG8_BAR;
        PG8_WAIT_V(2); PG8_BAR;
        PG8_STAGE(PG8_SB(1, 0), cB + kstep, voffB); PG8_STAGE(PG8_SA(1, 0), cA + kstep, voffA); PG8_STAGE(PG8_SB(1, 1), cB + hstep + kstep, voffB);
        PG8_WAIT_V(6); PG8_BAR;
    } else {
        PG8_STAGE(PG8_SB(0, 0), cB, voffB); PG8_STAGE(PG8_SA(0, 0), cA, voffA); PG8_STAGE(PG8_SB(0, 1), cB + hstep, voffB); PG8_STAGE(PG8_SA(0, 1), cA + hstep, voffA);
        if (wr == 1) PG8_BAR;
        PG8_WAIT_V(4); PG8_BAR;
        PG8_STAGE(PG8_SB(1, 0), cB + kstep, voffB); PG8_STAGE(PG8_SA(1, 0), cA + kstep, voffA); PG8_STAGE(PG8_SB(1, 1), cB + hstep + kstep, voffB);
        PG8_WAIT_V(6); PG8_BAR;
    }
    for (;;) {
        const bool has_next = S.next(ui + 1, nxt);
        const char* nA = has_next ? (const char*)g.A + (size_t)nxt.pm * tstep : cA; const char* nB = has_next ? (const char*)g.Bt + (size_t)nxt.pn * tstep : cB;
        for (int t = 0; t < nt; t += 2) {
            const bool last = (t == nt - 2);
            const char* a1 = cA + (size_t)(t + 1) * kstep;
            const char* a2 = last ? nA : cA + (size_t)(t + 2) * kstep; const char* b2 = last ? nB : cB + (size_t)(t + 2) * kstep;
            const char* a3 = a2 + kstep; const char* b3 = b2 + kstep;
            if (last && has_next) S.a_ready(nxt);
            if constexpr (SP2) {
            PG8_LDB(B0, 0, 0); PG8_LDB(B1, 0, 1); PG8_SCHED; PG8_LDA(At, 0, 0); PG8_STAGE(PG8_SA(1, 1), a1 + hstep, voffA);
            PG8_WAIT_V(8); PG8_WAIT_L(0); PG8_BAR; PG8_MMA(0, 0, At, B0); PG8_MMA(0, 1, At, B1); PG8_BAR; PG8_SCHED;
            PG8_LDA(At, 0, 1); PG8_STAGE(PG8_SB(0, 0), b2, voffB); PG8_STAGE(PG8_SB(0, 1), b2 + hstep, voffB); PG8_STAGE(PG8_SA(0, 0), a2, voffA);
            PG8_WAIT_V(8); PG8_WAIT_L(0); PG8_BAR; PG8_MMA(1, 0, At, B0); PG8_MMA(1, 1, At, B1); PG8_BAR; PG8_SCHED;
            PG8_LDB(B0, 1, 0); PG8_LDB(B1, 1, 1); PG8_SCHED; PG8_LDA(At, 1, 0); PG8_STAGE(PG8_SA(0, 1), a2 + hstep, voffA);
            PG8_WAIT_V(8); PG8_WAIT_L(0); PG8_BAR; PG8_MMA(0, 0, At, B0); PG8_MMA(0, 1, At, B1); PG8_BAR; PG8_SCHED;
            PG8_LDA(At, 1, 1); PG8_STAGE(PG8_SB(1, 0), b3, voffB); PG8_STAGE(PG8_SB(1, 1), b3 + hstep, voffB); PG8_STAGE(PG8_SA(1, 0), a3, voffA);
            PG8_WAIT_V(8); PG8_WAIT_L(0); PG8_BAR; PG8_MMA(1, 0, At, B0); PG8_MMA(1, 1, At, B1); PG8_BAR; PG8_SCHED;
            } else {
            PG8_LDB(B0, 0, 0); PG8_SCHED; PG8_LDA(At, 0, 0); PG8_STAGE(PG8_SA(1, 1), a1 + hstep, voffA);
            PG8_WAIT_L(8); PG8_BAR; PG8_WAIT_L(0); PG8_MMA(0, 0, At, B0); PG8_BAR; PG8_SCHED;
            PG8_LDB(B1, 0, 1); PG8_STAGE(PG8_SB(0, 0), b2, voffB);
            PG8_BAR; PG8_WAIT_L(0); PG8_MMA(0, 1, At, B1); PG8_BAR;
            PG8_LDA(At, 0, 1); PG8_STAGE(PG8_SA(0, 0), a2, voffA);
            PG8_BAR; PG8_WAIT_L(0); PG8_MMA(1, 0, At, B0); PG8_BAR; PG8_SCHED;
            PG8_STAGE(PG8_SB(0, 1), b2 + hstep, voffB);
            PG8_WAIT_V(6); PG8_BAR; PG8_MMA(1, 1, At, B1); PG8_BAR;
            PG8_LDB(B0, 1, 0); PG8_SCHED; PG8_LDA(At, 1, 0); PG8_STAGE(PG8_SA(0, 1), a2 + hstep, voffA);
            PG8_WAIT_L(8); PG8_BAR; PG8_WAIT_L(0); PG8_MMA(0, 0, At, B0); PG8_BAR; PG8_SCHED;
            PG8_LDB(B1, 1, 1); PG8_STAGE(PG8_SB(1, 0), b3, voffB);
            PG8_BAR; PG8_WAIT_L(0); PG8_MMA(0, 1, At, B1); PG8_BAR;
            PG8_LDA(At, 1, 1); PG8_STAGE(PG8_SA(1, 0), a3, voffA);
            PG8_BAR; PG8_WAIT_L(0); PG8_MMA(1, 0, At, B0); PG8_BAR; PG8_SCHED;
            PG8_STAGE(PG8_SB(1, 1), b3 + hstep, voffB);
            PG8_WAIT_V(6); PG8_BAR; PG8_MMA(1, 1, At, B1); PG8_BAR;
            }
        }
        if constexpr (ALIGN_EPI) { if (wr == 0) PG8_BAR; }
        if constexpr (Epi::HAS_PREFETCH) { E.run(acc, cur, wr, wc, fr, fq, lds, ui); S.done(cur); }
        else if constexpr (!Epi::AFTER_DRAIN) { E(acc, cur, wr, wc, fr, fq); S.done(cur); }
        if (!has_next) break;
#pragma unroll
        for (int a = 0; a < 2; ++a)
#pragma unroll
            for (int b = 0; b < 2; ++b)
#pragma unroll
                for (int m = 0; m < 4; ++m)
#pragma unroll
                    for (int n = 0; n < 2; ++n) acc[a][b][m][n] = (f32x4){0.f, 0.f, 0.f, 0.f};
        cur = nxt; cA = nA; cB = nB; ++ui;
        if constexpr (Epi::HAS_PREFETCH) E.prefetch(lds, cur, wid, lane, ui);
        if constexpr (ALIGN_EPI) { if (wr == 1) PG8_BAR; }
    }
    PG8_WAIT_V(0);
    if constexpr (!ALIGN_EPI) { if (wr == 0) PG8_BAR; }
    PG8_BAR;
    if constexpr (Epi::AFTER_DRAIN) { E.fused(acc, cur, wr, wc, fr, fq, lds, wid, lane); S.done(cur); }
#undef PG8_SA
#undef PG8_SB
#undef PG8_STAGE
#undef PG8_LDA
#undef PG8_LDB
#undef PG8_MMA
#undef PG8_WAIT_V
#undef PG8_WAIT_L
#undef PG8_BAR
#undef PG8_SCHED
}
}

#include <hip/hip_cooperative_groups.h>
namespace cg = cooperative_groups;
#ifndef MK_ONE_LAUNCH
#define MK_ONE_LAUNCH 1
#endif
#ifndef WGM_G1
#define WGM_G1 4
#endif
#ifndef WGM_G2
#define WGM_G2 4
#endif
#ifndef WGM_G3
#define WGM_G3 4
#endif
#ifndef WGM_G4
#define WGM_G4 4
#endif
constexpr int NWAVES = 8, NTHR = 512;
constexpr int NB = 16, SEQ = 4096, D = 1024, M = NB * SEQ, LCTX = 256, MCTX = NB * LCTX, NH = 4, DH = 128, RETW = 512, INW = 2560, DFF = 2816, NUP = 5632, NMOD = 6144;
constexpr float NORM_EPS = 1e-6f;
constexpr size_t MiB = 1u << 20;
constexpr size_t WS_CTL = 0, CTL_ZERO_BYTES = 1 * MiB;
constexpr size_t WS_TG2 = 256 * 1024;
constexpr size_t WS_TM = 384 * 1024;
constexpr size_t WS_MODP = 1 * MiB;
constexpr size_t WS_WIN = 5 * MiB, WS_WOUT = 10 * MiB, WS_WUP = 12 * MiB, WS_WDN = 23 * MiB;
constexpr size_t WS_SCTX = 29 * MiB;
constexpr size_t WS_HCTX = 38 * MiB;
constexpr size_t WS_WKV2 = 29 * MiB;
constexpr size_t WS_CKVP = 640 * MiB;
constexpr size_t WS_H = 64 * MiB;
constexpr size_t WS_PROJ = 192 * MiB;
constexpr size_t WS_MIXOUT = 192 * MiB;
constexpr size_t WS_ACT = 544 * MiB;
constexpr size_t WS_FFN = 320 * MiB;
constexpr size_t WS_X1B = 896 * MiB;
constexpr size_t QKVG_T = (size_t)NB * NH * SEQ * DH;
constexpr size_t PROJ_Y = 4 * QKVG_T;
constexpr size_t CKV_T = (size_t)NB * NH * LCTX * DH;
constexpr size_t WS_END = 1024 * MiB;
constexpr int LDS_BYTES = 147456;

#define LAS __attribute__((address_space(3)))
typedef unsigned short bf16;
typedef unsigned v4u __attribute__((ext_vector_type(4)));
typedef unsigned v2u __attribute__((ext_vector_type(2)));
typedef float f32x4 __attribute__((ext_vector_type(4)));
__device__ __forceinline__ unsigned f2bf(float f) { unsigned u = __builtin_bit_cast(unsigned, f); return (u + 0x7fffu + ((u >> 16) & 1u)) >> 16; }
__device__ __forceinline__ unsigned pk2(float lo, float hi) { unsigned r; asm("v_cvt_pk_bf16_f32 %0, %1, %2" : "=v"(r) : "v"(lo), "v"(hi)); return r; }
__device__ __forceinline__ float bf2f(unsigned short b) { return __builtin_bit_cast(float, ((unsigned)b) << 16); }
__device__ __forceinline__ float bflo(unsigned w) { return __builtin_bit_cast(float, w << 16); }
__device__ __forceinline__ float bfhi(unsigned w) { return __builtin_bit_cast(float, w & 0xffff0000u); }
__device__ __forceinline__ float silu_f(float x) { return x / (1.f + __expf(-x)); }
__device__ __forceinline__ float wave_sum(float v) {
#pragma unroll
    for (int o = 1; o < 64; o <<= 1) v += __shfl_xor(v, o);
    return v;
}

struct Args { const float* in[18]; float* out; unsigned char* ws; int ph_lo, ph_hi; };
struct Frame {
    unsigned char* lds; int tid, lane, wave, vcu, G;
    const float *x, *c, *ctx, *c_ctx, *w_ada, *b_ada, *g_mix_pre, *g_mix_post, *g_ffn_pre, *g_ffn_post, *w_in, *dec_f, *dec_b, *w_out, *w_up, *conv_w, *conv_b, *w_down;
    float* out; unsigned char* ws;
};

template <int MODE>
__device__ __forceinline__ void p0_transpose_item(const float* W, int K, int N, int nblk, bf16* WT, float* scr, int item, int lane) {
    const int kb = item / nblk, nb = item % nblk, k0 = 64 * kb, n0 = 32 * nb;
    int sc = n0 + (lane & 31);
    if (MODE == 1 && sc < 1024) { const int lc = sc & 127; sc = (sc & ~127) + 64 * ((lc >> 2) & 1) + 16 * (lc >> 5) + 4 * ((lc >> 3) & 3) + (lc & 3); }
    if (MODE == 2) { const int tcn = sc & 255; sc = (tcn >> 7) * 2816 + 128 * (sc >> 8) + (tcn & 127); }
    float wl[32];
#pragma unroll
    for (int i = 0; i < 32; ++i) { const int kk = 2 * i + (lane >> 5); int kr = k0 + kk;
        if (MODE == 3 && kr >= 512 && (kr & 127) > 64) kr = (kr & ~127) + 192 - (kr & 127);
        wl[i] = W[(size_t)kr * N + sc]; }
#pragma unroll
    for (int i = 0; i < 32; ++i) { const int kk = 2 * i + (lane >> 5); scr[kk * 33 + (lane & 31)] = wl[i]; }
    asm volatile("s_waitcnt lgkmcnt(0)" ::: "memory");
    const int c = lane & 7;
#pragma unroll
    for (int j = 0; j < 4; ++j) { const int n = (lane >> 3) + 8 * j; const float* s = scr + (8 * c) * 33 + n;
        v4u o; o.x = pk2(s[0 * 33], s[1 * 33]); o.y = pk2(s[2 * 33], s[3 * 33]); o.z = pk2(s[4 * 33], s[5 * 33]); o.w = pk2(s[6 * 33], s[7 * 33]);
        *(v4u*)(WT + (size_t)(n0 + n) * K + k0 + 8 * c) = o;
        if (MODE == 1 && n0 + n >= 512 && n0 + n < 1536) *(v4u*)((bf16*)((unsigned char*)WT - WS_WIN + WS_WKV2) + ((size_t)(k0 >> 9) * 1024 + (n0 + n - 512)) * 512 + (k0 & 511) + 8 * c) = o; }
    asm volatile("s_waitcnt lgkmcnt(0)" ::: "memory");
}

__device__ __forceinline__ void ph_prep_w(Frame& F) {
    __syncthreads();
    float* scr = (float*)(F.lds + F.wave * 16384);
    const int gw = F.vcu * NWAVES + F.wave, NGW = F.G * NWAVES;
    constexpr int I_IN = (D / 64) * (2048 / 32), I_OUT = (D / 64) * (D / 32), I_UP = (D / 64) * (NUP / 32), I_DN = (DFF / 64) * (D / 32);
    for (int it = gw; it < I_IN; it += NGW) p0_transpose_item<1>(F.w_in, D, INW, 64, (bf16*)(F.ws + WS_WIN), scr, it, F.lane);
    __syncthreads();
    {
        float* Wl = (float*)F.lds; float* tc = Wl + 16 * 128; float* ts = tc + 128;
        if (F.tid < 128) { tc[F.tid] = __builtin_amdgcn_cosf((float)F.tid * (1.f / 128.f)); ts[F.tid] = __builtin_amdgcn_sinf((float)F.tid * (1.f / 128.f)); }
        bf16* WT = (bf16*)(F.ws + WS_WIN);
        const float fsc = 0.0013810679320049757f;
        for (int it = blockIdx.x; it < 64 * 4; it += F.G) {
            const int kb = it >> 2, g = it & 3;
            __syncthreads();
            { float wq[4];
#pragma unroll
              for (int q = 0; q < 4; ++q) { const int i = F.tid + NTHR * q; wq[q] = F.w_in[(size_t)(kb * 16 + (i >> 7)) * INW + 2048 + g * 128 + (i & 127)]; }
#pragma unroll
              for (int q = 0; q < 4; ++q) Wl[F.tid + NTHR * q] = wq[q]; }
            __syncthreads();
            const int o = F.tid & 127, kq = F.tid >> 7, p = o >> 1, part = o & 1;
            float a0 = 0.f, a1 = 0.f, a2 = 0.f, a3 = 0.f;
            for (int c = 0; c < 128; ++c) {
                const int ix = (c * p) & 127;
                float cf = part ? -ts[ix] : tc[ix];
                if (p == 0 && part) cf = tc[(64 * c) & 127];
                a0 += Wl[(4 * kq + 0) * 128 + c] * cf; a1 += Wl[(4 * kq + 1) * 128 + c] * cf; a2 += Wl[(4 * kq + 2) * 128 + c] * cf; a3 += Wl[(4 * kq + 3) * 128 + c] * cf;
            }
            v2u w; w.x = pk2(a0 * fsc, a1 * fsc); w.y = pk2(a2 * fsc, a3 * fsc);
            *(v2u*)(WT + (size_t)(2048 + g * 128 + o) * D + kb * 16 + 4 * kq) = w;
        }
    }
    __syncthreads();
}
__device__ __forceinline__ void ph_prep_wrest(Frame& F, int gw, int NGW) {
    __syncthreads();
    float* scr = (float*)(F.lds + F.wave * 16384);
    constexpr int I_OUT = (D / 64) * (D / 32), I_UP = (D / 64) * (NUP / 32), I_DN = (DFF / 64) * (D / 32);
    for (int it = gw; it < I_OUT + I_UP + I_DN; it += NGW) {
        int r = it;
        if (r < I_OUT) { p0_transpose_item<3>(F.w_out, D, D, D / 32, (bf16*)(F.ws + WS_WOUT), scr, r, F.lane); continue; } r -= I_OUT;
        if (r < I_UP) { p0_transpose_item<2>(F.w_up, D, NUP, NUP / 32, (bf16*)(F.ws + WS_WUP), scr, r, F.lane); continue; } r -= I_UP;
        p0_transpose_item<0>(F.w_down, DFF, D, D / 32, (bf16*)(F.ws + WS_WDN), scr, r, F.lane);
    }
    __syncthreads();
}
__device__ __forceinline__ void ph_prep_ada(Frame& F) {
    __syncthreads();
    float* sil = (float*)F.lds;
    float* red = (float*)(F.lds + 16384);
    float* modp = (float*)(F.ws + WS_MODP);
    for (int it = blockIdx.x; it < 24 * 8; it += F.G) {
        const int jc = it % 24, kc = it / 24;
        const int col = jc * 256 + (F.tid & 255), kh = F.tid >> 8;
        float wv[64];
#pragma unroll
        for (int j = 0; j < 64; ++j) wv[j] = F.w_ada[(size_t)(kc * 128 + kh * 64 + j) * NMOD + col];
        { float cv[5];
#pragma unroll
          for (int q = 0; q < 5; ++q) { const int i = F.tid + NTHR * q, r = i >> 7, kk = i & 127; cv[q] = (i < 17 * 128) ? ((r < 16) ? F.c[r * D + kc * 128 + kk] : F.c_ctx[kc * 128 + kk]) : 0.f; }
#pragma unroll
          for (int q = 0; q < 5; ++q) { const int i = F.tid + NTHR * q; if (i < 17 * 128) sil[i] = silu_f(cv[q]); } }
        __syncthreads();
        float acc[17];
#pragma unroll
        for (int r = 0; r < 17; ++r) acc[r] = 0.f;
#pragma unroll
        for (int j = 0; j < 64; ++j) { const float w = wv[j];
#pragma unroll
            for (int r = 0; r < 17; ++r) acc[r] += sil[r * 128 + kh * 64 + j] * w; }
        if (kh == 1) {
#pragma unroll
            for (int r = 0; r < 17; ++r) red[r * 256 + (F.tid & 255)] = acc[r]; }
        __syncthreads();
        if (kh == 0) {
#pragma unroll
            for (int r = 0; r < 17; ++r) modp[(size_t)(kc * 17 + r) * NMOD + col] = acc[r] + red[r * 256 + (F.tid & 255)]; }
        __syncthreads();
    }
}
__device__ __forceinline__ float mod_val(const Frame& F, int mr, int ch, int col) {
    const float* modp = (const float*)(F.ws + WS_MODP); const int j = ch * D + col; float s = F.b_ada[j];
#pragma unroll
    for (int kc = 0; kc < 8; ++kc) s += modp[(size_t)(kc * 17 + mr) * NMOD + j];
    return s;
}
__device__ __forceinline__ void ph_norm1(Frame& F) {
    float* vA = (float*)F.lds; float* vB = vA + D; float* vAc = vB + D; float* vBc = vAc + D;
    for (int grp = blockIdx.x; grp < M / 256; grp += F.G) {
        const int mr = grp / 16;
        __syncthreads();
        for (int col = F.tid; col < D; col += NTHR) { const float gp = F.g_mix_pre[col];
            vA[col] = gp * (1.f + mod_val(F, mr, 1, col)); vB[col] = mod_val(F, mr, 0, col);
            vAc[col] = gp * (1.f + mod_val(F, 16, 1, col)); vBc[col] = mod_val(F, 16, 0, col); }
        __syncthreads();
        for (int r = 2 * F.wave; r < 256 + 16; r += 2 * NWAVES) {
            const bool is_ctx = r >= 256;
            const float* src = is_ctx ? F.ctx + ((size_t)grp * 16 + (r - 256)) * D : F.x + ((size_t)grp * 256 + r) * D;
            bf16* dst = is_ctx ? (bf16*)(F.ws + WS_HCTX) + ((size_t)grp * 16 + (r - 256)) * 512 : (bf16*)(F.ws + WS_H) + ((size_t)grp * 256 + r) * D;
            const float* pa = is_ctx ? vAc : vA; const float* pb = is_ctx ? vBc : vB;
            f32x4 v[2][4]; float ss[2];
#pragma unroll
            for (int q = 0; q < 2; ++q) { const f32x4* xr = (const f32x4*)(src + (size_t)q * D) + F.lane;
#pragma unroll
                for (int j = 0; j < 4; ++j) v[q][j] = xr[64 * j]; }
#pragma unroll
            for (int q = 0; q < 2; ++q) { ss[q] = 0.f;
#pragma unroll
                for (int j = 0; j < 4; ++j) ss[q] += (v[q][j].x * v[q][j].x + v[q][j].y * v[q][j].y) + (v[q][j].z * v[q][j].z + v[q][j].w * v[q][j].w); }
#pragma unroll
            for (int q = 0; q < 2; ++q) { const float rstd = rsqrtf(wave_sum(ss[q]) * (1.f / D) + NORM_EPS);
                unsigned long long* o8 = (unsigned long long*)(dst + (size_t)q * (is_ctx ? 512 : D)) + F.lane;
#pragma unroll
                for (int j = 0; j < 4; ++j) { const int c0 = 4 * F.lane + 256 * j; const f32x4 a = *(const f32x4*)(pa + c0), b = *(const f32x4*)(pb + c0);
                    const f32x4 h = v[q][j] * rstd * a + b;
                    unsigned long long* o8j = is_ctx ? o8 + (size_t)(j >> 1) * ((size_t)MCTX * 512 / 4) + 64 * (j & 1) : o8 + 64 * j;
                    *o8j = (unsigned long long)pk2(h.x, h.y) | ((unsigned long long)pk2(h.z, h.w) << 32); } }
        }
    }
}
__device__ __forceinline__ float log_gamma(const float* dec, int h) { const float xv = dec[h]; return -log1pf(expf(-xv)); }
constexpr size_t WS_ST = 512 * MiB;
typedef short s16x4 __attribute__((ext_vector_type(4)));
typedef short bf16x8 __attribute__((ext_vector_type(8)));
#define RET_KP 272
#define RET_VP 144
__device__ __forceinline__ bf16x8 tr2(LAS unsigned char* a0, LAS unsigned char* a1) {
    const s16x4 lo = __builtin_amdgcn_ds_read_tr16_b64_v4i16((LAS s16x4*)a0), hi = __builtin_amdgcn_ds_read_tr16_b64_v4i16((LAS s16x4*)a1);
    return __builtin_shufflevector(lo, hi, 0, 1, 2, 3, 4, 5, 6, 7);
}
__device__ __forceinline__ unsigned add_bf16x2(unsigned a, unsigned b) { return pk2(bflo(a) + bflo(b), bfhi(a) + bfhi(b)); }
__device__ __forceinline__ v4u add_bf16x8(v4u a, v4u b) { v4u r; r.x = add_bf16x2(a.x, b.x); r.y = add_bf16x2(a.y, b.y); r.z = add_bf16x2(a.z, b.z); r.w = add_bf16x2(a.w, b.w); return r; }
__device__ __forceinline__ v4u scale8(v4u w, float z) {
    v4u o;
#pragma unroll
    for (int j = 0; j < 4; ++j) o[j] = pk2(bflo(w[j]) * z, bfhi(w[j]) * z);
    return o;
}
__device__ __forceinline__ int r1_sw(int row) { return ((row & 3) << 1) | (((row >> 3) & 1) << 3); }
__device__ __forceinline__ void ph_ret_states_rs(Frame& F, LAS unsigned char* L, int ch) {
    const bf16* proj = (const bf16*)(F.ws + WS_PROJ); const bf16* ckv = (const bf16*)(F.ws + WS_CKVP); bf16* ST = (bf16*)(F.ws + WS_ST);
    const int w = F.wave, l = F.lane;
    constexpr int TILEB = 128 * 256, BUFB = 2 * TILEB;
    const int dir = ch & 1, h = (ch >> 1) & 3, b = ch >> 3;
    const float l2 = log_gamma(dir ? F.dec_b : F.dec_f, h) * 1.4426950408889634f;
    __syncthreads();
#define RS_SRC(s, kp, vp) do { const int n_ = dir ? 31 - ((s) - 2) : (s) - 2; kp = proj + QKVG_T + ((size_t)(b * NH + h) * SEQ + n_ * 128) * DH; vp = kp + QKVG_T; } while (0)
    if (w < 4) {
        const int lt = F.tid;
        float zv[8]; int woff[8];
#pragma unroll
        for (int i = 0; i < 8; ++i) { const int qi = lt + 256 * i, c = qi >> 4; zv[i] = exp2f((float)(dir ? c : 127 - c) * l2); woff[i] = c * 256 + (((qi & 15) ^ r1_sw(c)) << 4); }
        v4u kA[8], vA[8], kB[8], vB[8];
#define RS_ISSUE(s, kr, vr) do { const bf16* kp_; const bf16* vp_; RS_SRC(s, kp_, vp_); \
            _Pragma("unroll") for (int i = 0; i < 8; ++i) { const int qi = lt + 256 * i; kr[i] = *(const v4u*)(kp_ + qi * 8); vr[i] = *(const v4u*)(vp_ + qi * 8); } } while (0)
#define RS_WRITE(buf, kr, vr) do { LAS unsigned char* kb_ = L + (buf) * BUFB; LAS unsigned char* vb_ = kb_ + TILEB; \
            _Pragma("unroll") for (int i = 0; i < 8; ++i) { *(LAS v4u*)(kb_ + woff[i]) = kr[i]; *(LAS v4u*)(vb_ + woff[i]) = scale8(vr[i], zv[i]); } } while (0)
#define RS_ISSUE_CTX(s, kr, vr, kr2, vr2) do { const int cchunk = dir ? 1 - (s) : (s); const bf16* kp_ = ckv + ((size_t)(b * NH + h) * LCTX + cchunk * 128) * DH; const bf16* vp_ = kp_ + CKV_T; \
            _Pragma("unroll") for (int i = 0; i < 8; ++i) { const int qi = lt + 256 * i; kr[i] = *(const v4u*)(kp_ + qi * 8); vr[i] = *(const v4u*)(vp_ + qi * 8); \
                kr2[i] = *(const v4u*)(kp_ + 2 * CKV_T + qi * 8); vr2[i] = *(const v4u*)(vp_ + 2 * CKV_T + qi * 8); } \
            _Pragma("unroll") for (int i = 0; i < 8; ++i) { kr[i] = add_bf16x8(kr[i], kr2[i]); vr[i] = add_bf16x8(vr[i], vr2[i]); } } while (0)
        RS_ISSUE_CTX(0, kA, vA, kB, vB); RS_WRITE(0, kA, vA);
        __syncthreads();
        RS_ISSUE_CTX(1, kA, vA, kB, vB); RS_ISSUE(2, kB, vB);
#undef RS_ISSUE_CTX
#pragma unroll 1
        for (int s = 0; s < 34; s += 2) {
            const int s3 = (s + 3 < 34) ? s + 3 : 33, s4 = (s + 4 < 34) ? s + 4 : 33;
            RS_WRITE(1, kA, vA); __syncthreads(); RS_ISSUE(s3, kA, vA);
            RS_WRITE(0, kB, vB); __syncthreads(); RS_ISSUE(s4, kB, vB);
        }
#undef RS_ISSUE
#undef RS_WRITE
    } else {
        const int cw = w - 4, wd = cw >> 1, we = cw & 1, fq = l >> 4, g = l >> 4, q = (l & 15) >> 2, p = l & 3;
        const float cd = exp2f(128.f * l2);
        const int trow = 8 * g + q, tsw = r1_sw(trow);
        int aoff[4], boff[4];
#pragma unroll
        for (int mf = 0; mf < 4; ++mf) { aoff[mf] = trow * 256 + ((((8 * wd + 2 * mf) + (p >> 1)) ^ tsw) << 4) + (p & 1) * 8; boff[mf] = trow * 256 + ((((8 * we + 2 * mf) + (p >> 1)) ^ tsw) << 4) + (p & 1) * 8; }
        pg8::f32x4 acc[4][4];
#pragma unroll
        for (int mf = 0; mf < 4; ++mf)
#pragma unroll
            for (int nf = 0; nf < 4; ++nf) acc[mf][nf] = (pg8::f32x4){0.f, 0.f, 0.f, 0.f};
#define RS_STEP(s, buf, ST_) do { \
            if (ST_) { const int n = dir ? 31 - ((s) - 2) : (s) - 2; \
                bf16* sp = ST + ((size_t)(((b * NH + h) * 2 + dir) * 32 + n) << 14) + (size_t)(64 * we + (l & 15)) * DH + 64 * wd + 4 * fq; \
                _Pragma("unroll") for (int mf = 0; mf < 4; ++mf) _Pragma("unroll") for (int nf = 0; nf < 4; ++nf) { v2u o; o.x = pk2(acc[mf][nf][0], acc[mf][nf][1]); o.y = pk2(acc[mf][nf][2], acc[mf][nf][3]); *(v2u*)(sp + nf * 16 * DH + mf * 16) = o; } } \
            _Pragma("unroll") for (int mf = 0; mf < 4; ++mf) _Pragma("unroll") for (int nf = 0; nf < 4; ++nf) acc[mf][nf] = acc[mf][nf] * cd; \
            LAS unsigned char* kb = L + (buf) * BUFB; LAS unsigned char* vb = kb + TILEB; \
            _Pragma("unroll") for (int ks = 0; ks < 4; ++ks) { bf16x8 Bv[4]; \
                _Pragma("unroll") for (int nf = 0; nf < 4; ++nf) { LAS unsigned char* va = vb + boff[nf] + ks * 32 * 256; Bv[nf] = tr2(va, va + 4 * 256); } \
                _Pragma("unroll") for (int mf = 0; mf < 4; ++mf) { LAS unsigned char* ka = kb + aoff[mf] + ks * 32 * 256; const bf16x8 A = tr2(ka, ka + 4 * 256); \
                    _Pragma("unroll") for (int nf = 0; nf < 4; ++nf) acc[mf][nf] = __builtin_amdgcn_mfma_f32_16x16x32_bf16(A, Bv[nf], acc[mf][nf], 0, 0, 0); } } } while (0)
        __syncthreads();
        RS_STEP(0, 0, false); __syncthreads();
        RS_STEP(1, 1, false); __syncthreads();
#pragma unroll 1
        for (int s = 2; s < 34; s += 2) {
            RS_STEP(s, 0, true); __syncthreads();
            RS_STEP(s + 1, 1, true); __syncthreads();
        }
#undef RS_STEP
    }
#undef RS_SRC
}
__device__ __forceinline__ void ph_ret_out(Frame& F, LAS unsigned char* L) {
    const __amdgpu_buffer_rsrc_t rp = __builtin_amdgcn_make_buffer_rsrc((void*)(F.ws + WS_PROJ), (short)0, (int)((size_t)M * INW * 2), 0x00020000);
    const __amdgpu_buffer_rsrc_t rs = __builtin_amdgcn_make_buffer_rsrc((void*)(F.ws + WS_ST), (short)0, (int)((size_t)NB * NH * 2 * 32 * 16384 * 2), 0x00020000);
    const __amdgpu_buffer_rsrc_t rm = __builtin_amdgcn_make_buffer_rsrc((void*)(F.ws + WS_H), (short)0, (int)((size_t)M * D * 2), 0x00020000);
    const int w = F.wave, l = F.lane, fq = l >> 4, g = l >> 4, q = (l & 15) >> 2, p = l & 3, li = l & 15;
    constexpr int TB = 128 * RET_KP;
    LAS unsigned char* Kt = L; LAS unsigned char* Vt = L + TB; LAS unsigned char* Tf = L + 2 * TB; LAS unsigned char* Tb = L + 3 * TB;
    const int iloc = 16 * w + li;
    v4u r0[4], r1[4];
    int vkv[4], vst[4];
#pragma unroll
    for (int i = 0; i < 4; ++i) { const int qi = F.tid + 512 * i; vkv[i] = qi * 16; vst[i] = qi * 16; }
    const int vq = (iloc * DH + 8 * fq) * 2, vg = (iloc * DH + 4 * fq) * 2, vo = (iloc * D + 4 * fq) * 2;
#define R2_ISSUE_KV(it) do { const int n_ = (it) & 31, h_ = ((it) >> 5) & 3, b_ = (it) >> 7; const int s0_ = (((b_ * NH + h_) * SEQ + n_ * 128) * DH) * 2; \
        _Pragma("unroll") for (int i = 0; i < 4; ++i) { r0[i] = __builtin_amdgcn_raw_buffer_load_b128(rp, vkv[i], s0_ + (int)(QKVG_T * 2), 0); r1[i] = __builtin_amdgcn_raw_buffer_load_b128(rp, vkv[i], s0_ + (int)(2 * QKVG_T * 2), 0); } } while (0)
#define R2_ISSUE_Q(it, dst) do { const int n_ = (it) & 31, h_ = ((it) >> 5) & 3, b_ = (it) >> 7; const int s0_ = (((b_ * NH + h_) * SEQ + n_ * 128) * DH) * 2; \
        _Pragma("unroll") for (int ks = 0; ks < 4; ++ks) dst[ks] = __builtin_amdgcn_raw_buffer_load_b128(rp, vq + ks * 64, s0_, 0); } while (0)
    v4u Qn[4];
    if ((int)blockIdx.x < NB * NH * 32) { R2_ISSUE_KV((int)blockIdx.x); R2_ISSUE_Q((int)blockIdx.x, Qn); }
    for (int item = blockIdx.x; item < NB * NH * 32; item += F.G) {
        const int n = item & 31, h = (item >> 5) & 3, b = item >> 7;
        const size_t tok0 = (size_t)b * SEQ + n * 128;
        int ilo = iloc; asm volatile("" : "+v"(ilo));
        const float l2f = log_gamma(F.dec_f, h) * 1.4426950408889634f, l2b = log_gamma(F.dec_b, h) * 1.4426950408889634f;
        bf16x8 Qf[4];
#pragma unroll
        for (int ks = 0; ks < 4; ++ks) Qf[ks] = __builtin_bit_cast(bf16x8, Qn[ks]);
#pragma unroll
        for (int i = 0; i < 4; ++i) { const int qi = F.tid + 512 * i, off = (qi >> 4) * RET_KP + (qi & 15) * 16; *(LAS v4u*)(Kt + off) = r0[i]; *(LAS v4u*)(Vt + off) = r1[i]; }
        __syncthreads();
        v4u r2[4], r3[4];
        { const int sf = ((((b * NH + h) * 2 + 0) * 32 + n) << 15), sb = ((((b * NH + h) * 2 + 1) * 32 + n) << 15);
#pragma unroll
          for (int i = 0; i < 4; ++i) { r2[i] = __builtin_amdgcn_raw_buffer_load_b128(rs, vst[i], sf, 0); r3[i] = __builtin_amdgcn_raw_buffer_load_b128(rs, vst[i], sb, 0); } }
        bf16x8 Pk[4];
#pragma unroll
        for (int hv = 0; hv < 2; ++hv) {
            pg8::f32x4 st[4];
#pragma unroll
            for (int m4 = 0; m4 < 4; ++m4) { const int mf = 4 * hv + m4; st[m4] = (pg8::f32x4){0.f, 0.f, 0.f, 0.f};
#pragma unroll
                for (int ks = 0; ks < 4; ++ks) { const bf16x8 A = *(const LAS bf16x8*)(Kt + (16 * mf + li) * RET_KP + (32 * ks + 8 * fq) * 2);
                    st[m4] = __builtin_amdgcn_mfma_f32_16x16x32_bf16(A, Qf[ks], st[m4], 0, 0, 0); } }
#pragma unroll
            for (int s2 = 0; s2 < 2; ++s2) { const int s = 2 * hv + s2; float v[8];
#pragma unroll
                for (int hh = 0; hh < 2; ++hh)
#pragma unroll
                    for (int r = 0; r < 4; ++r) { const int j = 32 * s + 16 * hh + 4 * fq + r; const int dd = ilo - j;
                        const float dm = exp2f(dd >= 0 ? (float)dd * l2f : (float)(-dd) * l2b); v[4 * hh + r] = st[2 * s2 + hh][r] * dm; }
                v4u pkd; pkd.x = pk2(v[0], v[1]); pkd.y = pk2(v[2], v[3]); pkd.z = pk2(v[4], v[5]); pkd.w = pk2(v[6], v[7]);
                Pk[s] = __builtin_bit_cast(bf16x8, pkd); }
            asm volatile("" ::: "memory");
        }
        pg8::f32x4 ot[8];
#pragma unroll
        for (int mf = 0; mf < 8; ++mf) { pg8::f32x4 o = (pg8::f32x4){0.f, 0.f, 0.f, 0.f};
#pragma unroll
            for (int s = 0; s < 4; ++s) { LAS unsigned char* va = Vt + (32 * s + 4 * g + q) * RET_KP + (16 * mf + 4 * p) * 2;
                const bf16x8 A = tr2(va, va + 16 * RET_KP);
                o = __builtin_amdgcn_mfma_f32_16x16x32_bf16(A, Pk[s], o, 0, 0, 0); }
            ot[mf] = o; }
#pragma unroll
        for (int i = 0; i < 4; ++i) { const int qi = F.tid + 512 * i, off = (qi >> 4) * RET_KP + (qi & 15) * 16; *(LAS v4u*)(Tf + off) = r2[i]; *(LAS v4u*)(Tb + off) = r3[i]; }
        __syncthreads();
        if (item + F.G < NB * NH * 32) { R2_ISSUE_KV(item + F.G); R2_ISSUE_Q(item + F.G, Qn); }
        const float xf = exp2f((float)(iloc + 1) * l2f), xb = exp2f((float)(128 - iloc) * l2b);
        const int sg = (((b * NH + h) * SEQ + n * 128) * DH) * 2 + (int)(3 * QKVG_T * 2), so = (int)((tok0 * D + h * DH) * 2);
        v2u gw[8];
#pragma unroll
        for (int mf = 0; mf < 8; ++mf) gw[mf] = __builtin_amdgcn_raw_buffer_load_b64(rp, vg + 32 * mf, sg, 0);
        float ss = 0.f;
#pragma unroll
        for (int mf = 0; mf < 8; ++mf) {
            pg8::f32x4 c1 = (pg8::f32x4){0.f, 0.f, 0.f, 0.f}, c2 = c1;
#pragma unroll
            for (int ks = 0; ks < 4; ++ks) { const bf16x8 Af = *(const LAS bf16x8*)(Tf + (16 * mf + li) * RET_KP + (32 * ks + 8 * fq) * 2);
                const bf16x8 Ab = *(const LAS bf16x8*)(Tb + (16 * mf + li) * RET_KP + (32 * ks + 8 * fq) * 2);
                c1 = __builtin_amdgcn_mfma_f32_16x16x32_bf16(Af, Qf[ks], c1, 0, 0, 0);
                c2 = __builtin_amdgcn_mfma_f32_16x16x32_bf16(Ab, Qf[ks], c2, 0, 0, 0); }
            const pg8::f32x4 o = ot[mf] + c1 * xf + c2 * xb; ot[mf] = o; ss += (o[0] * o[0] + o[1] * o[1]) + (o[2] * o[2] + o[3] * o[3]);
        }
        ss += __shfl_xor(ss, 16); ss += __shfl_xor(ss, 32);
        const float rstd = rsqrtf(ss * (1.f / DH) + NORM_EPS);
#pragma unroll
        for (int mf = 0; mf < 8; ++mf) { const v2u gv = gw[mf];
            v2u o; o.x = pk2(ot[mf][0] * rstd * silu_f(bflo(gv.x)), ot[mf][1] * rstd * silu_f(bfhi(gv.x))); o.y = pk2(ot[mf][2] * rstd * silu_f(bflo(gv.y)), ot[mf][3] * rstd * silu_f(bfhi(gv.y)));
            __builtin_amdgcn_raw_buffer_store_b64(o, rm, vo + 32 * mf, so, 0); }
    }
#undef R2_ISSUE_KV
#undef R2_ISSUE_Q
}
typedef float cf2 __attribute__((ext_vector_type(2)));
__device__ __forceinline__ cf2 cmul(cf2 a, cf2 b) { return cf2{a.x * b.x - a.y * b.y, a.x * b.y + a.y * b.x}; }
template <int CTRL> __device__ __forceinline__ float qperm(float x) { return __int_as_float(__builtin_amdgcn_update_dpp(0, __float_as_int(x), CTRL, 0xf, 0xf, false)); }
__device__ __forceinline__ cf2 cswapneg(cf2 a) { return cf2{a.y, -a.x}; }
__device__ __forceinline__ cf2 cmulv(cf2 a, cf2 w, cf2 wr) { return __builtin_elementwise_fma(cf2{a.y, a.y}, wr, cf2{a.x, a.x} * w); }
__device__ __forceinline__ void dft4v(cf2& a0, cf2& a1, cf2& a2, cf2& a3) {
    const cf2 s02 = a0 + a2, d02 = a0 - a2, s13 = a1 + a3, d13 = a1 - a3, r = cswapneg(d13);
    a0 = s02 + s13; a2 = s02 - s13; a1 = d02 + r; a3 = d02 - r;
}
__device__ __forceinline__ void fft16v(cf2 (&v)[16]) {
#pragma unroll
    for (int m0 = 0; m0 < 4; ++m0) dft4v(v[m0], v[4 + m0], v[8 + m0], v[12 + m0]);
    constexpr float C1 = 0.92387953251128674f, S1 = 0.38268343236508977f, C2 = 0.70710678118654752f;
#define FT16(i, wc_, ws_) v[i] = cmulv(v[i], cf2{wc_, ws_}, cf2{-(ws_), wc_})
    FT16(5, C1, -S1); FT16(6, C2, -C2); FT16(7, S1, -C1);
    FT16(9, C2, -C2); v[10] = cswapneg(v[10]); FT16(11, -C2, -C2);
    FT16(13, S1, -C1); FT16(14, -C2, -C2); FT16(15, -C1, S1);
#undef FT16
#pragma unroll
    for (int q = 0; q < 4; ++q) dft4v(v[4 * q], v[4 * q + 1], v[4 * q + 2], v[4 * q + 3]);
}
struct QuadCtx { cf2 tw[16]; cf2 sg, kA, kB; };
__device__ __forceinline__ void quad_ctx(QuadCtx& Q, int n0) {
    const float n0r = (float)n0 * (1.f / 64.f);
#pragma unroll
    for (int s = 1; s < 16; ++s) { const int q = (s >> 2) + 4 * (s & 3); const float ang = n0r * (float)q; Q.tw[s] = cf2{__builtin_amdgcn_cosf(ang), -__builtin_amdgcn_sinf(ang)}; }
    const float sg = (n0 & 2) ? -1.f : 1.f; Q.sg = cf2{sg, sg};
    Q.kA = (n0 == 0) ? cf2{1.f, 1.f} : (n0 == 2) ? cf2{-1.f, -1.f} : cf2{0.f, 0.f};
    Q.kB = (n0 == 1) ? cf2{1.f, -1.f} : (n0 == 3) ? cf2{-1.f, 1.f} : cf2{0.f, 0.f};
}
template <int CTRL> __device__ __forceinline__ cf2 qperm2(cf2 v) { return cf2{qperm<CTRL>(v.x), qperm<CTRL>(v.y)}; }
__device__ __forceinline__ void fft64_quadv(cf2 (&a)[16], const QuadCtx& Q) {
    fft16v(a);
#pragma unroll
    for (int s = 1; s < 16; ++s) a[s] = cmulv(a[s], Q.tw[s], cf2{-Q.tw[s].y, Q.tw[s].x});
#pragma unroll
    for (int s = 0; s < 16; ++s) {
        const cf2 t = __builtin_elementwise_fma(a[s], Q.sg, qperm2<0x4E>(a[s]));
        const cf2 E = qperm2<0x88>(t), O = qperm2<0xDD>(t);
        a[s] = __builtin_elementwise_fma(cf2{O.y, O.x}, Q.kB, __builtin_elementwise_fma(O, Q.kA, E));
    }
}
__device__ __forceinline__ int fft_row(int l1, int l2) { return 64 * l1 + ((l2 + 2 * (l1 & 3)) & 63); }
__device__ __forceinline__ void ph_fft2(Frame& F, LAS unsigned char* L, int first, int stride) {
    const __amdgpu_buffer_rsrc_t ry = __builtin_amdgcn_make_buffer_rsrc((void*)(F.ws + WS_PROJ + PROJ_Y * 2), (short)0, (int)((size_t)M * 512 * 2), 0x00020000);
    const __amdgpu_buffer_rsrc_t rm = __builtin_amdgcn_make_buffer_rsrc((void*)(F.ws + WS_H), (short)0, (int)((size_t)M * D * 2), 0x00020000);
    LAS unsigned char* IM = L + 131072;
    const int n0 = F.tid & 3, quad = F.tid >> 2, c = quad & 7, qh = quad >> 3;
    QuadCtx Q; quad_ctx(Q, n0);
#define FFT_ITEM(i0_) ((stride == 128) ? (((first & 7) + 8 * (((first >> 3) >> 3) + 2 * ((i0_) >> 7))) * 8 + ((first >> 3) & 7)) : (i0_))
    v4u w[16];
    { const int itf = FFT_ITEM((first < NB * 4 * 8) ? first : 0);
#pragma unroll
      for (int i = 0; i < 16; ++i) w[i] = __builtin_amdgcn_raw_buffer_load_b128(ry, (F.tid + 512 * i) * 16, itf * 131072, 0); }
    for (int it0 = first; it0 < NB * 4 * 8; it0 += stride) {
        const int it = FFT_ITEM(it0);
        const int cb = it & 7, bg = it >> 3, b = bg >> 2, g = bg & 3;
        __syncthreads();
#pragma unroll
        for (int i = 0; i < 16; ++i) { const int q = F.tid + 512 * i, tok = q >> 1; *(LAS v4u*)(L + fft_row(tok >> 6, tok & 63) * 32 + (q & 1) * 16) = w[i]; }
        __syncthreads();
#pragma unroll 1
        for (int ps = 0; ps < 4; ++ps) { const int l2 = 16 * ps + qh; int n0o = n0; asm volatile("" : "+v"(n0o));
            cf2 a[16];
#pragma unroll
            for (int n1 = 0; n1 < 16; ++n1) { const unsigned w = *(const LAS unsigned*)(L + fft_row(4 * n1 + n0o, l2) * 32 + c * 4); a[n1] = cf2{bflo(w), bfhi(w)}; }
            fft64_quadv(a, Q);
            const float l2r = (float)l2 * (1.f / 4096.f);
#pragma unroll
            for (int s = 0; s < 16; ++s) { const int q = (s >> 2) + 4 * (s & 3), l1p = q + 16 * n0o; const float ang = l2r * (float)l1p;
                const cf2 o = cmul(a[s], cf2{__builtin_amdgcn_cosf(ang), -__builtin_amdgcn_sinf(ang)});
                *(LAS unsigned*)(L + fft_row(l1p, l2) * 32 + c * 4) = pk2(o.x, o.y); } }
        __syncthreads();
#pragma unroll 1
        for (int ps = 0; ps < 4; ++ps) { const int l1p = 16 * ps + qh; int n0o = n0; asm volatile("" : "+v"(n0o));
            cf2 a[16];
#pragma unroll
            for (int n1 = 0; n1 < 16; ++n1) { const unsigned w = *(const LAS unsigned*)(L + fft_row(l1p, 4 * n1 + n0o) * 32 + c * 4); a[n1] = cf2{bflo(w), bfhi(w)}; }
            fft64_quadv(a, Q);
#pragma unroll
            for (int s = 0; s < 16; ++s) { const int q = (s >> 2) + 4 * (s & 3), k = q + 16 * n0o;
                *(LAS float*)(L + fft_row(l1p, k) * 32 + c * 4) = a[s].x;
                if (cb == 0 && c == 0) *(LAS unsigned short*)(IM + (l1p + 64 * k) * 2) = (unsigned short)f2bf(a[s].y); } }
        __syncthreads();
        { const int itn = FFT_ITEM((it0 + stride < NB * 4 * 8) ? it0 + stride : it0);
#pragma unroll
          for (int i = 0; i < 16; ++i) w[i] = __builtin_amdgcn_raw_buffer_load_b128(ry, (F.tid + 512 * i) * 16, itn * 131072, 0); }
        const int obase = ((b * SEQ) * D + 512 + g * 128 + 8 * cb) * 2;
#pragma unroll 2
        for (int i = 0; i < 8; ++i) { const int lp = F.tid + 512 * i, m = (SEQ - lp) & (SEQ - 1);
            const LAS unsigned char* rp_ = L + fft_row(lp & 63, lp >> 6) * 32;
            const f32x4 lo = *(const LAS f32x4*)rp_, hi = *(const LAS f32x4*)(rp_ + 16);
            float d0 = lo.x, m0 = lo.x;
            if (cb == 0) { const float rem = *(const LAS float*)(L + fft_row(m & 63, m >> 6) * 32);
                const float iml = bf2f(*(const LAS unsigned short*)(IM + lp * 2)), imm = bf2f(*(const LAS unsigned short*)(IM + m * 2));
                d0 = 0.5f * (lo.x + rem); m0 = 0.5f * (iml + imm); }
            v4u o; o.y = pk2(lo.z, lo.w); o.z = pk2(hi.x, hi.y); o.w = pk2(hi.z, hi.w);
            o.x = pk2(d0, lo.y); __builtin_amdgcn_raw_buffer_store_b128(o, rm, lp * D * 2, obase, 0);
            o.x = pk2(m0, lo.y); __builtin_amdgcn_raw_buffer_store_b128(o, rm, m * D * 2 + 128, obase, 0); }
    }
#undef FFT_ITEM
}
__device__ __forceinline__ void ph_mid(Frame& F) {
    float* vG = (float*)F.lds; float* vA = vG + D; float* vB = vA + D;
    const bf16* mo = (const bf16*)(F.ws + WS_MIXOUT); bf16* hf = (bf16*)(F.ws + WS_H);
    typedef float f32x2 __attribute__((ext_vector_type(2)));
    const f32x2* tm = (const f32x2*)(F.ws + WS_TM);
    f32x2 pre[3];
#pragma unroll
    for (int k = 0; k < 3; ++k) pre[k] = tm[k * (D / 2) + F.tid];
    for (int b = 0; b < NB; ++b) {
        __syncthreads();
#pragma unroll
        for (int k = 0; k < 3; ++k) ((f32x2*)vG)[k * (D / 2) + F.tid] = pre[k];
        __syncthreads();
        if (b + 1 < NB) {
#pragma unroll
            for (int k = 0; k < 3; ++k) pre[k] = tm[(size_t)(b + 1) * 3 * (D / 2) + k * (D / 2) + F.tid]; }
        for (int rb = blockIdx.x; rb < SEQ / 16; rb += F.G) {
            const size_t row0 = (size_t)b * SEQ + (size_t)rb * 16 + 2 * F.wave;
            f32x4 v[2][4], xv[2][4]; float ss[2];
#pragma unroll
            for (int q = 0; q < 2; ++q) { const size_t row = row0 + q;
                const v2u* mr4 = (const v2u*)(mo + row * D) + F.lane; const f32x4* xr = (const f32x4*)(F.x + row * D) + F.lane;
#pragma unroll
                for (int j = 0; j < 4; ++j) { const v2u w = mr4[64 * j]; v[q][j] = (f32x4){bflo(w.x), bfhi(w.x), bflo(w.y), bfhi(w.y)}; xv[q][j] = xr[64 * j]; } }
#pragma unroll
            for (int q = 0; q < 2; ++q) { ss[q] = 0.f;
#pragma unroll
                for (int j = 0; j < 4; ++j) ss[q] += (v[q][j].x * v[q][j].x + v[q][j].y * v[q][j].y) + (v[q][j].z * v[q][j].z + v[q][j].w * v[q][j].w); }
#pragma unroll
            for (int q = 0; q < 2; ++q) { const float rstd = rsqrtf(wave_sum(ss[q]) * (1.f / D) + NORM_EPS); float s1 = 0.f;
#pragma unroll
                for (int j = 0; j < 4; ++j) { const int c0 = 4 * F.lane + 256 * j; const f32x4 g = *(const f32x4*)(vG + c0);
                    v[q][j] = xv[q][j] + v[q][j] * rstd * g; s1 += (v[q][j].x * v[q][j].x + v[q][j].y * v[q][j].y) + (v[q][j].z * v[q][j].z + v[q][j].w * v[q][j].w); }
                ss[q] = s1; }
#pragma unroll
            for (int q = 0; q < 2; ++q) { const float rstd1 = rsqrtf(wave_sum(ss[q]) * (1.f / D) + NORM_EPS); const size_t row = row0 + q;
                unsigned long long* o8 = (unsigned long long*)(hf + row * D) + F.lane; unsigned long long* x8 = (unsigned long long*)((bf16*)(F.ws + WS_X1B) + row * D) + F.lane;
#pragma unroll
                for (int j = 0; j < 4; ++j) { const int c0 = 4 * F.lane + 256 * j; const f32x4 a = *(const f32x4*)(vA + c0), bb = *(const f32x4*)(vB + c0);
                    const f32x4 h = v[q][j] * rstd1 * a + bb;
                    x8[64 * j] = (unsigned long long)pk2(v[q][j].x, v[q][j].y) | ((unsigned long long)pk2(v[q][j].z, v[q][j].w) << 32);
                    o8[64 * j] = (unsigned long long)pk2(h.x, h.y) | ((unsigned long long)pk2(h.z, h.w) << 32); } }
        }
    }
}
__device__ __forceinline__ void ph_gate_table(Frame& F) {
    if ((int)blockIdx.x < 64 && F.tid < 256) { const int b = (int)blockIdx.x >> 2, col = 256 * ((int)blockIdx.x & 3) + F.tid;
        ((float*)(F.ws + WS_TG2))[b * D + col] = F.g_ffn_post[col] * mod_val(F, b, 5, col);
        float* tm = (float*)(F.ws + WS_TM) + (size_t)b * 3 * D;
        tm[col] = F.g_mix_post[col] * mod_val(F, b, 2, col); tm[D + col] = F.g_ffn_pre[col] * (1.f + mod_val(F, b, 4, col)); tm[2 * D + col] = mod_val(F, b, 3, col); }
}
__device__ __forceinline__ void ph_final(Frame& F) {
    float* vG2 = (float*)F.lds; const bf16* ff = (const bf16*)(F.ws + WS_FFN); const bf16* x1b = (const bf16*)(F.ws + WS_X1B);
    __syncthreads();
    { const f32x4* tg = (const f32x4*)(F.ws + WS_TG2);
      for (int i = F.tid; i < NB * D / 4; i += NTHR) ((f32x4*)vG2)[i] = tg[i]; }
    __syncthreads();
    for (int b = 0; b < NB; ++b)
    for (int rb = blockIdx.x; rb < SEQ / 16; rb += F.G) {
        const size_t row0 = (size_t)b * SEQ + (size_t)rb * 16 + 2 * F.wave;
        f32x4 v[2][4], xv[2][4]; float ss[2];
#pragma unroll
        for (int q = 0; q < 2; ++q) { const size_t row = row0 + q;
            const v2u* fr4 = (const v2u*)(ff + row * D) + F.lane; const v2u* xr = (const v2u*)(x1b + row * D) + F.lane;
#pragma unroll
            for (int j = 0; j < 4; ++j) { const v2u w = fr4[64 * j]; v[q][j] = (f32x4){bflo(w.x), bfhi(w.x), bflo(w.y), bfhi(w.y)};
                const v2u w2 = xr[64 * j]; xv[q][j] = (f32x4){bflo(w2.x), bfhi(w2.x), bflo(w2.y), bfhi(w2.y)}; } }
#pragma unroll
        for (int q = 0; q < 2; ++q) { ss[q] = 0.f;
#pragma unroll
            for (int j = 0; j < 4; ++j) ss[q] += (v[q][j].x * v[q][j].x + v[q][j].y * v[q][j].y) + (v[q][j].z * v[q][j].z + v[q][j].w * v[q][j].w); }
#pragma unroll
        for (int q = 0; q < 2; ++q) { const float rstd = rsqrtf(wave_sum(ss[q]) * (1.f / D) + NORM_EPS);
            f32x4* orow = (f32x4*)(F.out + (row0 + q) * D) + F.lane;
#pragma unroll
            for (int j = 0; j < 4; ++j) { const int c0 = 4 * F.lane + 256 * j; const f32x4 g2 = *(const f32x4*)(vG2 + b * D + c0);
                orow[64 * j] = xv[q][j] + v[q][j] * rstd * g2; } }
    }
}
#define XB_TMO      128
#define XB_XCNT(j)  (256  + 64 * (j))
#define XB_XSUB(j)  (1280 + 64 * (j))
#define XB_XGEN(j)  (2304 + 64 * (j))
#define XB_TOP      3328
#define XB_TOPGEN   3392
#define XCD_BAR_WORDS 3456
#define XB_SPIN_CAP (1u << 18)

__device__ __forceinline__ unsigned xb_ld(unsigned* p)              { return __hip_atomic_load(p, __ATOMIC_RELAXED, __HIP_MEMORY_SCOPE_AGENT); }
__device__ __forceinline__ unsigned xb_add(unsigned* p, unsigned v) { return __hip_atomic_fetch_add(p, v, __ATOMIC_RELAXED, __HIP_MEMORY_SCOPE_AGENT); }
__device__ __forceinline__ unsigned xb_xcc_id() { return (unsigned)__builtin_amdgcn_s_getreg((3 << 11) | 20) & 0xFu; }
#define XB_SPIN(cond, bar) do { unsigned _sp = 0; while (cond) { __builtin_amdgcn_s_sleep(1); \
    if ((++_sp & 255u) == 0u) { if (xb_ld(&(bar)[XB_TMO])) break; if (_sp > XB_SPIN_CAP) { atomicAdd(&(bar)[XB_TMO], 1u); break; } } } } while (0)

struct XcdBarrier {
    unsigned* bar; unsigned x;
    volatile LAS unsigned* st;
};

__device__ __forceinline__ XcdBarrier xcd_barrier_post(unsigned* bar, volatile LAS unsigned* st) {
    XcdBarrier b; b.bar = bar; b.x = xb_xcc_id(); b.st = st;
    if (threadIdx.x == 0) (void)xb_add(&bar[XB_XCNT(b.x)], 1u);
    return b;
}
__device__ __forceinline__ void xcd_barrier_complete(unsigned* bar, unsigned x, unsigned& nloc, unsigned& nx) {
    const unsigned G = gridDim.x * gridDim.y * gridDim.z;
    unsigned sum, cnt, mine, sp = 0u;
    for (;;) {
        sum = 0u; cnt = 0u; mine = 0u;
#pragma unroll
        for (unsigned j = 0; j < 16; ++j) { const unsigned c = xb_ld(&bar[XB_XCNT(j)]); sum += c; cnt += (c > 0u) ? 1u : 0u; mine = (j == x) ? c : mine; }
        if (sum == G) break;
        __builtin_amdgcn_s_sleep(1);
        if ((++sp & 255u) == 0u) { if (xb_ld(&bar[XB_TMO])) break; if (sp > XB_SPIN_CAP) { atomicAdd(&bar[XB_TMO], 1u); break; } }
    }
    nloc = mine > 0u ? mine : 1u; nx = cnt > 0u ? cnt : 1u;
}

__device__ __forceinline__ void xcd_barrier(const XcdBarrier& b) {
    asm volatile("s_waitcnt vmcnt(0)" ::: "memory");
    __syncthreads();
    if (threadIdx.x == 0) {
        unsigned* bar = b.bar;
        __builtin_amdgcn_s_waitcnt(0);
        unsigned nloc = b.st[0], nx = b.st[1];
        if (nloc == 0u) { xcd_barrier_complete(bar, b.x, nloc, nx); b.st[0] = nloc; b.st[1] = nx; }
        const unsigned old = xb_add(&bar[XB_XSUB(b.x)], 1u);
        const unsigned gen = old / nloc;
        if (old + 1u == (gen + 1u) * nloc) {
            __builtin_amdgcn_fence(__ATOMIC_RELEASE, "agent");
            asm volatile("s_waitcnt vmcnt(0)" ::: "memory");
            const unsigned og = xb_add(&bar[XB_TOP], 1u);
            const unsigned tg = og / nx;
            if (og + 1u == (tg + 1u) * nx) xb_add(&bar[XB_TOPGEN], 1u);
            else XB_SPIN(xb_ld(&bar[XB_TOPGEN]) == tg, bar);
            __builtin_amdgcn_fence(__ATOMIC_ACQUIRE, "agent");
            xb_add(&bar[XB_XGEN(b.x)], 1u);
            asm volatile("s_waitcnt vmcnt(0)" ::: "memory");
        } else {
            XB_SPIN(xb_ld(&bar[XB_XGEN(b.x)]) == gen, bar);
            __builtin_amdgcn_fence(__ATOMIC_ACQUIRE, "agent");
            asm volatile("s_waitcnt vmcnt(0)" ::: "memory");
        }
    }
    __syncthreads();
}

constexpr int CW_BAR = 4096;
constexpr int LDS_BARST = LDS_BYTES - 256;
enum { PH_PREP = 0, PH_NORM1, PH_G1, PH_RSTATE, PH_ROUT, PH_G2, PH_MID, PH_G3, PH_G4, PH_FINAL, PH_COUNT };

__global__ void __launch_bounds__(NTHR, 2) mega(Args args) {
    extern __shared__ __attribute__((aligned(16))) unsigned char lds[];
    Frame F;
    F.lds = lds; F.tid = threadIdx.x; F.lane = F.tid & 63; F.wave = __builtin_amdgcn_readfirstlane(F.tid >> 6);
    F.G = gridDim.x; { const int bx = blockIdx.x; F.vcu = (F.G % 8 == 0) ? (bx % 8) * (F.G / 8) + bx / 8 : bx; }
    F.x = args.in[0]; F.c = args.in[1]; F.ctx = args.in[2]; F.c_ctx = args.in[3]; F.w_ada = args.in[4]; F.b_ada = args.in[5];
    F.g_mix_pre = args.in[6]; F.g_mix_post = args.in[7]; F.g_ffn_pre = args.in[8]; F.g_ffn_post = args.in[9]; F.w_in = args.in[10];
    F.dec_f = args.in[11]; F.dec_b = args.in[12]; F.w_out = args.in[13]; F.w_up = args.in[14]; F.conv_w = args.in[15]; F.conv_b = args.in[16]; F.w_down = args.in[17];
    F.out = args.out; F.ws = args.ws;
    PG8_LAS unsigned char* ldsl = (PG8_LAS unsigned char*)lds;
    const int lo = args.ph_lo, hi = args.ph_hi;
#define IN(k) (lo <= (k) && (k) < hi)
#define REFRESH() do { int t_ = threadIdx.x; asm volatile("" : "+v"(t_)); F.tid = t_; F.lane = t_ & 63; } while (0)
    volatile LAS unsigned* barst = (volatile LAS unsigned*)((LAS unsigned char*)ldsl + LDS_BARST);
    if (threadIdx.x < 2) barst[threadIdx.x] = 0u;
    __syncthreads();
    const XcdBarrier xbar = xcd_barrier_post((unsigned*)(args.ws + WS_CTL) + CW_BAR, barst);
    if (lo < 0) cg::this_grid().sync();
#define SEAM(k) do { if (IN(k) && IN((k) + 1)) xcd_barrier(xbar); } while (0)
    if (IN(PH_PREP)) { REFRESH(); ph_prep_ada(F); }
    SEAM(PH_PREP);
    if (IN(PH_NORM1)) { REFRESH(); ph_gate_table(F); if (blockIdx.x & 1) { REFRESH(); ph_prep_w(F); REFRESH(); ph_norm1(F); } else { REFRESH(); ph_norm1(F); REFRESH(); ph_prep_w(F); } }
    SEAM(PH_NORM1);
    if (IN(PH_G1)) {
        { pg8::Gemm g{(const bf16*)(F.ws + WS_H), (const bf16*)(F.ws + WS_WIN), M, INW, D}; pg8::StaticOrder S; S.init(M, INW, F.G, (int)blockIdx.x, WGM_G1);
          pg8::EpiInProj E{(bf16*)(F.ws + WS_PROJ), 0}; pg8::gemm_phase<pg8::EpiInProj, pg8::StaticOrder, true, true>(ldsl, g, S, E); }
        for (int kh2 = 0; kh2 < 2; ++kh2) {
            pg8::Gemm g{(const bf16*)(F.ws + WS_HCTX) + (size_t)kh2 * MCTX * 512, (const bf16*)(F.ws + WS_WKV2) + (size_t)kh2 * 1024 * 512, MCTX, 2 * RETW, 512}; pg8::StaticOrder S; S.init(MCTX, 2 * RETW, F.G, (F.G >= 128) ? (int)blockIdx.x - 64 * kh2 : (int)blockIdx.x, WGM_G1);
            pg8::EpiInProj E{(bf16*)(F.ws + WS_CKVP) + (size_t)kh2 * 2 * CKV_T, 1}; pg8::gemm_phase<pg8::EpiInProj, pg8::StaticOrder, true, true>(ldsl, g, S, E); }
        if (F.G > 128) { if ((int)blockIdx.x >= 128) { REFRESH(); ph_prep_wrest(F, ((int)blockIdx.x - 128) * NWAVES + F.wave, (F.G - 128) * NWAVES); } }
        else { REFRESH(); ph_prep_wrest(F, (int)blockIdx.x * NWAVES + F.wave, F.G * NWAVES); }
    }
    SEAM(PH_G1);
    if (IN(PH_RSTATE)) { const int half_id = (int)(((blockIdx.x >> 4) << 3) | (blockIdx.x & 7));
        if (F.G != 256) { REFRESH(); for (int ch = blockIdx.x; ch < 128; ch += F.G) ph_ret_states_rs(F, (LAS unsigned char*)ldsl, ch); REFRESH(); ph_fft2(F, (LAS unsigned char*)ldsl, (int)blockIdx.x, F.G); }
        else if (((blockIdx.x >> 3) & 1) == 0) { REFRESH(); ph_ret_states_rs(F, (LAS unsigned char*)ldsl, half_id); }
        else { REFRESH(); ph_fft2(F, (LAS unsigned char*)ldsl, half_id, 128); } }
    SEAM(PH_RSTATE);
    if (IN(PH_ROUT)) { REFRESH(); ph_ret_out(F, (LAS unsigned char*)ldsl); }
    SEAM(PH_ROUT);
    if (IN(PH_G2)) { pg8::Gemm g{(const bf16*)(F.ws + WS_H), (const bf16*)(F.ws + WS_WOUT), M, D, D}; pg8::StaticOrder S; S.init(M, D, F.G, (int)blockIdx.x, WGM_G2);
        pg8::EpiBf16 E{(bf16*)(F.ws + WS_MIXOUT), D}; pg8::gemm_phase<pg8::EpiBf16, pg8::StaticOrder, true, true>(ldsl, g, S, E); }
    SEAM(PH_G2);
    if (IN(PH_MID)) { REFRESH(); ph_mid(F); }
    SEAM(PH_MID);
    if (IN(PH_G3)) { pg8::Gemm g{(const bf16*)(F.ws + WS_H), (const bf16*)(F.ws + WS_WUP), M, NUP, D}; pg8::StaticOrder S; S.init(M, NUP, F.G, (int)blockIdx.x, WGM_G3);
        pg8::EpiUp E{(bf16*)(F.ws + WS_ACT), F.conv_w, F.conv_b}; pg8::gemm_phase<pg8::EpiUp, pg8::StaticOrder, true, true>(ldsl, g, S, E); }
    SEAM(PH_G3);
    if (IN(PH_G4)) { pg8::Gemm g{(const bf16*)(F.ws + WS_ACT), (const bf16*)(F.ws + WS_WDN), M, D, DFF}; pg8::StaticOrder S; S.init(M, D, F.G, (int)blockIdx.x, WGM_G4);
        pg8::EpiBf16 E{(bf16*)(F.ws + WS_FFN), D}; pg8::gemm_phase<pg8::EpiBf16, pg8::StaticOrder, true, true>(ldsl, g, S, E); }
    SEAM(PH_G4);
    if (IN(PH_FINAL)) { REFRESH(); ph_final(F); }
#undef IN
}

extern "C" void kernel_launch(void* const* d_in, const int* in_sizes, int n_in, void* d_out, int out_size, void* d_ws, size_t ws_size, hipStream_t stream) {
    static int grid = 0;
    if (grid == 0) {
        if (n_in != 18 || out_size != M * D || ws_size < WS_END) { fprintf(stderr, "kernel_launch: unexpected shapes n_in %d out %d ws %zu\n", n_in, out_size, ws_size); grid = -1; return; }
        int dev = 0, cus = 0;
        if (hipGetDevice(&dev) != hipSuccess || hipDeviceGetAttribute(&cus, hipDeviceAttributeMultiprocessorCount, dev) != hipSuccess) { grid = -1; return; }
        if (hipFuncSetAttribute((const void*)mega, hipFuncAttributeMaxDynamicSharedMemorySize, LDS_BYTES) != hipSuccess) { fprintf(stderr, "hipFuncSetAttribute failed\n"); grid = -1; return; }
        int per_cu = 0;
        if (hipOccupancyMaxActiveBlocksPerMultiprocessor(&per_cu, (const void*)mega, NTHR, LDS_BYTES) != hipSuccess || per_cu < 1) { fprintf(stderr, "occupancy query: %d\n", per_cu); grid = -1; return; }
        grid = cus * per_cu;
    }
    if (grid < 0) return;
    if (hipMemsetAsync((char*)d_ws + WS_CTL, 0, 65536, stream) != hipSuccess) { fprintf(stderr, "memset failed\n"); return; }
    Args a{};
    for (int i = 0; i < 18; ++i) a.in[i] = (const float*)d_in[i];
    a.out = (float*)d_out; a.ws = (unsigned char*)d_ws;
#if MK_ONE_LAUNCH
    a.ph_lo = 0; a.ph_hi = PH_COUNT;
    void* kargs[] = {&a};
    hipError_t e = hipLaunchCooperativeKernel((const void*)mega, dim3(grid), dim3(NTHR), kargs, LDS_BYTES, stream);
    if (e != hipSuccess) fprintf(stderr, "cooperative launch failed: %s (grid %d)\n", hipGetErrorString(e), grid);
#else
    for (int ph = 0; ph < PH_COUNT; ++ph) { a.ph_lo = ph; a.ph_hi = ph + 1; hipLaunchKernelGGL(mega, dim3(grid), dim3(NTHR), LDS_BYTES, stream, a); }
#endif
}
```

```cpp
#include <hip/hip_runtime.h>
#include <cstdio>
#include <cstdint>
namespace pg8 {
#define PG8_LAS __attribute__((address_space(3)))
typedef unsigned short bf16_t;
typedef short bf16x8 __attribute__((ext_vector_type(8)));
typedef float f32x4 __attribute__((ext_vector_type(4)));
typedef unsigned u32x4 __attribute__((ext_vector_type(4)));
constexpr int BM = 256, BK = 64, HALF = 128, HTB = HALF * BK * 2  , STAGE_BYTES = 8 * HTB, NXCD = 8, WGM = 8;

__host__ __device__ __forceinline__ int lds_byte(int r, int c) { const int st = (r >> 4) * 2 + (c >> 5), rr = r & 15, cc = c & 31, ob = rr * 64 + cc * 2; return st * 1024 + (ob ^ (((ob >> 9) & 1) << 5)); }
__host__ __device__ __forceinline__ void stage_rc(int b, int& R, int& C) { const int st = b / 1024, sb = b % 1024, swz = sb ^ (((sb >> 9) & 1) << 5); R = (st >> 1) * 16 + swz / 64; C = (st & 1) * 32 + (swz % 64) / 2; }
__host__ __device__ __forceinline__ int perm32(int rho) { const int n = rho >> 4, i = rho & 15; return 8 * (i >> 2) + 4 * n + (i & 3); }

struct Unit { int pm, pn; };
struct Gemm { const bf16_t* A; const bf16_t* Bt; int M, N, K; };

struct StaticOrder {
    int nM, nN, nwg, G, c, wgm;
    __host__ __device__ void init(int M, int N, int G_, int c_, int wgm_ = 4) { nM = M / BM; nN = N / BM; nwg = nM * nN; G = G_; c = c_; wgm = wgm_; }
    __host__ __device__ bool next(int i, Unit& u) const {
        const long L = (long)i * G + c; if (L >= nwg) return false;
        int wgid = (int)L; { const int q = nwg / NXCD, r = nwg % NXCD, xcd = wgid % NXCD, off = wgid / NXCD; wgid = (xcd < r ? xcd * (q + 1) : r * (q + 1) + (xcd - r) * q) + off; }
        const int nig = wgm * nN, gid = wgid / nig, fm = gid * wgm, gsz = (nM - fm) < wgm ? (nM - fm) : wgm;
        u.pm = fm + ((wgid % nig) % gsz); u.pn = (wgid % nig) / gsz; return true;
    }
    __device__ __forceinline__ void a_ready(const Unit&) const {}
    __device__ __forceinline__ void done(const Unit&) const {}
};

__device__ __forceinline__ unsigned cvt_pk_bf16(float lo, float hi) { unsigned r; asm volatile("v_cvt_pk_bf16_f32 %0, %1, %2" : "=v"(r) : "v"(lo), "v"(hi)); return r; }
struct EpiF32 {
    static constexpr bool PERM = false, AFTER_DRAIN = false, PERMA = false, HAS_PREFETCH = false;
    float* C; int ldc;
    __device__ __forceinline__ void operator()(const f32x4 (&acc)[2][2][4][2], const Unit& u, int wr, int wc, int fr, int fq) const {
        const int row0 = u.pm * BM + wr * 64 + fr, col0 = u.pn * BM + wc * 32 + 4 * fq;
#pragma unroll
        for (int ai = 0; ai < 2; ++ai)
#pragma unroll
            for (int m = 0; m < 4; ++m) { float* rowp = C + (size_t)(row0 + ai * HALF + m * 16) * ldc + col0;
#pragma unroll
                for (int bj = 0; bj < 2; ++bj)
#pragma unroll
                    for (int n = 0; n < 2; ++n) *(f32x4*)(rowp + bj * HALF + n * 16) = acc[ai][bj][m][n]; }
    }
};
struct EpiBf16 {
    static constexpr bool PERM = true, AFTER_DRAIN = false, PERMA = false, HAS_PREFETCH = false;
    bf16_t* O; int ldc;
    __device__ __forceinline__ void operator()(const f32x4 (&acc)[2][2][4][2], const Unit& u, int wr, int wc, int fr, int fq) const {
        const int row0 = u.pm * BM + wr * 64 + fr; const int col0 = u.pn * BM + wc * 32 + 8 * fq;
#pragma unroll
        for (int ai = 0; ai < 2; ++ai)
#pragma unroll
            for (int m = 0; m < 4; ++m) { bf16_t* rowp = O + (size_t)(row0 + ai * HALF + m * 16) * ldc + col0;
#pragma unroll
                for (int bj = 0; bj < 2; ++bj) { const f32x4 v0 = acc[ai][bj][m][0], v1 = acc[ai][bj][m][1];
                    u32x4 w; w.x = cvt_pk_bf16(v0[0], v0[1]); w.y = cvt_pk_bf16(v0[2], v0[3]); w.z = cvt_pk_bf16(v1[0], v1[1]); w.w = cvt_pk_bf16(v1[2], v1[3]);
                    *(u32x4*)(rowp + bj * HALF) = w; } }
    }
};

struct EpiInProj {
    static constexpr bool PERM = true, AFTER_DRAIN = false, PERMA = false, HAS_PREFETCH = false;
    bf16_t* O; int mode;
    __device__ __forceinline__ void store8(bf16_t* p, f32x4 v0, f32x4 v1) const {
        u32x4 w; w.x = cvt_pk_bf16(v0[0], v0[1]); w.y = cvt_pk_bf16(v0[2], v0[3]); w.z = cvt_pk_bf16(v1[0], v1[1]); w.w = cvt_pk_bf16(v1[2], v1[3]); *(u32x4*)p = w; }
    __device__ __forceinline__ void operator()(const f32x4 (&acc)[2][2][4][2], const Unit& u, int wr, int wc, int fr, int fq) const {
        const float KS = 0.08838834764831845f;
        constexpr size_t NHc = 4, SEQc = 4096, DHc = 128, LCc = 256, QKVG_T = (size_t)16 * NHc * SEQc * DHc;
        size_t base, bjstep; int pitch;
        if (mode == 0) {
            if (u.pn < 8) { base = (size_t)(u.pn >> 1) * QKVG_T + (((size_t)(u.pm >> 4) * NHc + 2 * (u.pn & 1)) * SEQc + (size_t)(u.pm & 15) * BM) * DHc; bjstep = SEQc * DHc; pitch = (int)DHc; }
            else { base = 4 * QKVG_T + (((((size_t)(u.pm >> 4) * 4 + 2 * (u.pn - 8)) * 8 + 2 * wc + (fq >> 1)) * SEQc + (size_t)(u.pm & 15) * BM) * 16 + 8 * (fq & 1)) - (size_t)(wc * 32 + 8 * fq);
                   bjstep = (size_t)8 * SEQc * 16; pitch = 16; }
        } else { base = (size_t)(u.pn >> 1) * (16 * NHc * LCc * DHc) + (((size_t)u.pm * NHc + 2 * (u.pn & 1)) * LCc) * DHc; bjstep = LCc * DHc; pitch = (int)DHc; }
        bf16_t* Ob = O + base + wc * 32 + 8 * fq;
        const int rl0 = wr * 64 + fr;
        if (mode == 0 && u.pn < 4) {
            int fqo = fq; asm volatile("" : "+v"(fqo));
            f32x4 rv;
#pragma unroll
            for (int j = 0; j < 4; ++j) rv[j] = exp2f(-(float)(16 * (wc & 1) + 4 * fqo + j) * (13.287712379549449f / 32.f)) * 0.15915494309189535f;
            const float ks = (u.pn >= 2) ? KS : 1.f;
            if (wc < 2) {
#pragma unroll
                for (int ai = 0; ai < 2; ++ai) { const float pos = (float)((4 * u.pm + 2 * ai + wr) & 63); f32x4 cs, sn;
#pragma unroll
                    for (int j = 0; j < 4; ++j) { const float a = pos * rv[j]; cs[j] = __builtin_amdgcn_cosf(a) * ks; sn[j] = __builtin_amdgcn_sinf(a) * ks; }
#pragma unroll
                    for (int m = 0; m < 4; ++m) { bf16_t* rowp = Ob + (size_t)(rl0 + ai * HALF + m * 16) * pitch;
#pragma unroll
                        for (int bj = 0; bj < 2; ++bj) { const f32x4 t1 = acc[ai][bj][m][0], t2 = acc[ai][bj][m][1]; store8(rowp + bj * bjstep, t1 * cs - t2 * sn, t1 * sn + t2 * cs); } }
                    asm volatile("" ::: "memory"); }
            } else {
#pragma unroll
                for (int m = 0; m < 4; ++m) { const float pos = (float)(16 * m + fr); f32x4 cs, sn;
#pragma unroll
                    for (int j = 0; j < 4; ++j) { const float a = pos * rv[j]; cs[j] = __builtin_amdgcn_cosf(a) * ks; sn[j] = __builtin_amdgcn_sinf(a) * ks; }
#pragma unroll
                    for (int ai = 0; ai < 2; ++ai) { bf16_t* rowp = Ob + (size_t)(rl0 + ai * HALF + m * 16) * pitch;
#pragma unroll
                        for (int bj = 0; bj < 2; ++bj) { const f32x4 t1 = acc[ai][bj][m][0], t2 = acc[ai][bj][m][1]; store8(rowp + bj * bjstep, t1 * cs - t2 * sn, t1 * sn + t2 * cs); } }
                    asm volatile("" ::: "memory"); }
            }
        } else {
            const float sc = (mode == 1 && u.pn < 2) ? KS : 1.f;
#pragma unroll
            for (int ai = 0; ai < 2; ++ai)
#pragma unroll
                for (int m = 0; m < 4; ++m) { bf16_t* rowp = Ob + (size_t)(rl0 + ai * HALF + m * 16) * pitch;
#pragma unroll
                    for (int bj = 0; bj < 2; ++bj) store8(rowp + bj * bjstep, acc[ai][bj][m][0] * sc, acc[ai][bj][m][1] * sc); }
        }
    }
};
__device__ __forceinline__ f32x4 dpp_shr1(f32x4 v) { f32x4 r;
#pragma unroll
    for (int j = 0; j < 4; ++j) { const float x = v[j]; r[j] = __int_as_float(__builtin_amdgcn_update_dpp(0, __float_as_int(x), 0x111, 0xf, 0xf, true)); }
    return r; }
__device__ __forceinline__ f32x4 dpp_shl1(f32x4 v) { f32x4 r;
#pragma unroll
    for (int j = 0; j < 4; ++j) { const float x = v[j]; r[j] = __int_as_float(__builtin_amdgcn_update_dpp(0, __float_as_int(x), 0x101, 0xf, 0xf, true)); }
    return r; }
struct EpiUp {
    static constexpr bool PERM = true, AFTER_DRAIN = false, PERMA = true, HAS_PREFETCH = true;
    bf16_t* O; const float* cw; const float* cb;
    typedef float f32x2 __attribute__((ext_vector_type(2)));
    typedef unsigned u32x2 __attribute__((ext_vector_type(2)));
    static constexpr int CONV_LDS = STAGE_BYTES;
    __device__ __forceinline__ void prefetch(PG8_LAS unsigned char* lds, const Unit& u, int wid, int lane, int ui) const {
        if (wid < 4) { const int q = wid * 64 + lane, vec = q >> 5, part = q & 31; constexpr int NUPc = 5632, DFFc = 2816;
            const float* src = ((vec & 3) == 3 ? cb : cw + (vec & 3) * NUPc) + (vec >> 2) * DFFc + u.pn * HALF + part * 4;
            __builtin_amdgcn_global_load_lds((const unsigned*)src, (PG8_LAS unsigned*)(lds + CONV_LDS + (ui & 1) * 4096 + wid * 1024), 16, 0, 0); }
    }
    static __device__ __forceinline__ f32x2 fma2(f32x2 a, f32x2 b, f32x2 c) { return __builtin_elementwise_fma(a, b, c); }
    __device__ __forceinline__ void run(const f32x4 (&acc)[2][2][4][2], const Unit& u, int wr, int wc, int fr, int fq, PG8_LAS unsigned char* lds, int ui) const {
        constexpr int DFFc = 2816;
        const float SA = -1.4426950408889634f, SB = -0.6931471805599453f;
        u32x2 keep[2][4];
#pragma unroll
        for (int n = 0; n < 2; ++n) {
            const PG8_LAS f32x4* cv = (const PG8_LAS f32x4*)(lds + CONV_LDS + (ui & 1) * 4096 + (wc * 32 + 8 * fq + 4 * n) * 4);
            const f32x4 wa0 = cv[0] * SA, wa1 = cv[32] * SA, wa2 = cv[64] * SA, ba = cv[96] * SA;
            const f32x4 wb0 = cv[128] * SB, wb1 = cv[160] * SB, wb2 = cv[192] * SB, bb = cv[224] * SB;
#pragma unroll
            for (int ai = 0; ai < 2; ++ai) {
                bf16_t* rowp = O + (size_t)(u.pm * BM + ai * HALF + wr * 64 + 4 * fr) * DFFc + (u.pn * HALF + wc * 32 + 8 * fq);
                const f32x4 pa = dpp_shr1(acc[ai][0][3][n]), pb = dpp_shr1(acc[ai][1][3][n]), na = dpp_shl1(acc[ai][0][0][n]), nb = dpp_shl1(acc[ai][1][0][n]);
#pragma unroll
                for (int m = 0; m < 4; ++m) {
                    const f32x4 ap = (m == 0) ? pa : acc[ai][0][m == 0 ? 0 : m - 1][n], bp = (m == 0) ? pb : acc[ai][1][m == 0 ? 0 : m - 1][n];
                    const f32x4 an = (m == 3) ? na : acc[ai][0][m == 3 ? 3 : m + 1][n], bn = (m == 3) ? nb : acc[ai][1][m == 3 ? 3 : m + 1][n];
                    const f32x4 ac = acc[ai][0][m][n], bc = acc[ai][1][m][n];
                    f32x2 alo = fma2(wa1.lo, ac.lo, ba.lo), ahi = fma2(wa1.hi, ac.hi, ba.hi), blo = fma2(wb1.lo, bc.lo, bb.lo), bhi = fma2(wb1.hi, bc.hi, bb.hi);
                    alo = fma2(wa0.lo, ap.lo, alo); ahi = fma2(wa0.hi, ap.hi, ahi); blo = fma2(wb0.lo, bp.lo, blo); bhi = fma2(wb0.hi, bp.hi, bhi);
                    alo = fma2(wa2.lo, an.lo, alo); ahi = fma2(wa2.hi, an.hi, ahi); blo = fma2(wb2.lo, bn.lo, blo); bhi = fma2(wb2.hi, bn.hi, bhi);
                    f32x2 elo, ehi; elo.x = __builtin_amdgcn_exp2f(alo.x); elo.y = __builtin_amdgcn_exp2f(alo.y); ehi.x = __builtin_amdgcn_exp2f(ahi.x); ehi.y = __builtin_amdgcn_exp2f(ahi.y);
                    elo = elo + 1.f; ehi = ehi + 1.f;
                    f32x2 rlo, rhi; rlo.x = __builtin_amdgcn_rcpf(elo.x); rlo.y = __builtin_amdgcn_rcpf(elo.y); rhi.x = __builtin_amdgcn_rcpf(ehi.x); rhi.y = __builtin_amdgcn_rcpf(ehi.y);
                    const f32x2 olo = (alo * blo) * rlo, ohi = (ahi * bhi) * rhi;
                    u32x2 w; w.x = cvt_pk_bf16(olo.x, olo.y); w.y = cvt_pk_bf16(ohi.x, ohi.y);
                    if (n == 0) keep[ai][m] = w;
                    else { u32x4 w4; w4.x = keep[ai][m].x; w4.y = keep[ai][m].y; w4.z = w.x; w4.w = w.y; *(u32x4*)(rowp + (size_t)m * DFFc) = w4; }
                }
                asm volatile("" ::: "memory");
            }
        }
    }
};
template <class Epi, class Sched, bool ALIGN_EPI = false, bool SP2 = false>
__device__ __forceinline__ void gemm_phase(PG8_LAS unsigned char* lds, const Gemm g, const Sched& S, const Epi& E) {
    int tid_o = threadIdx.x; asm volatile("" : "+v"(tid_o));
    const int tid = tid_o, wid = __builtin_amdgcn_readfirstlane(tid >> 6), lane = tid & 63, wr = wid >> 2, wc = wid & 3, fr = lane & 15, fq = lane >> 4;
    const int K = g.K, nt = K / BK;
    unsigned voffA[2], voffB[2];
#pragma unroll
    for (int i = 0; i < 2; ++i) { int R, C; stage_rc(tid * 16 + i * 8192, R, C); const int Rb = Epi::PERM ? ((R & ~31) + perm32(R & 31)) : R;
        const int Ra = Epi::PERMA ? ((R & ~63) | ((R & 15) << 2) | ((R >> 4) & 3)) : R;
        voffA[i] = (unsigned)(Ra * K + C) * 2u; voffB[i] = (unsigned)(Rb * K + C) * 2u; }
    const size_t kstep = (size_t)(BK * 2);
    const size_t hstep = (size_t)HALF * K * 2;
    const size_t tstep = 2 * hstep;
    const unsigned ldsw = (unsigned)wid * 1024u;
    const int aoff = lds_byte(wr * 64 + fr, fq * 8), boff = lds_byte(wc * 32 + fr, fq * 8);
#define PG8_SA(b, h) (((b) * 2 + (h)) * HTB)
#define PG8_SB(b, h) ((4 + (b) * 2 + (h)) * HTB)
#define PG8_STAGE(bufoff, gbase, voff) do { _Pragma("unroll") for (int _i = 0; _i < 2; ++_i) \
        __builtin_amdgcn_global_load_lds((const unsigned*)((const char*)(gbase) + (voff)[_i]), (PG8_LAS unsigned*)(lds + (bufoff) + ldsw + _i * 8192), 16, 0, 0); } while (0)
#define PG8_LDA(dst, b, h) do { _Pragma("unroll") for (int m = 0; m < 4; ++m) _Pragma("unroll") for (int k = 0; k < 2; ++k) dst[m][k] = *(const PG8_LAS bf16x8*)(lds + PG8_SA(b, h) + aoff + m * 2048 + k * 1024); } while (0)
#define PG8_LDB(dst, b, h) do { _Pragma("unroll") for (int n = 0; n < 2; ++n) _Pragma("unroll") for (int k = 0; k < 2; ++k) dst[n][k] = *(const PG8_LAS bf16x8*)(lds + PG8_SB(b, h) + boff + n * 2048 + k * 1024); } while (0)
#define PG8_MMA(ai, bj, At, Bt) do { __builtin_amdgcn_s_setprio(1); _Pragma("unroll") for (int m = 0; m < 4; ++m) _Pragma("unroll") for (int n = 0; n < 2; ++n) _Pragma("unroll") for (int k = 0; k < 2; ++k) \
        acc[ai][bj][m][n] = __builtin_amdgcn_mfma_f32_16x16x32_bf16(Bt[n][k], At[m][k], acc[ai][bj][m][n], 0, 0, 0); __builtin_amdgcn_s_setprio(0); } while (0)
#define PG8_WAIT_V(n) asm volatile("s_waitcnt vmcnt(" #n ")" ::: "memory")
#define PG8_WAIT_L(n) asm volatile("s_waitcnt lgkmcnt(" #n ")" ::: "memory")
#define PG8_BAR __builtin_amdgcn_s_barrier()
#define PG8_SCHED __builtin_amdgcn_sched_barrier(0)
    Unit cur, nxt; int ui = 0;
    if (!S.next(0, cur)) return;
    f32x4 acc[2][2][4][2];
#pragma unroll
    for (int a = 0; a < 2; ++a)
#pragma unroll
        for (int b = 0; b < 2; ++b)
#pragma unroll
            for (int m = 0; m < 4; ++m)
#pragma unroll
                for (int n = 0; n < 2; ++n) acc[a][b][m][n] = (f32x4){0.f, 0.f, 0.f, 0.f};
    bf16x8 At[4][2], B0[2][2], B1[2][2];
    const char* cA = (const char*)g.A + (size_t)cur.pm * tstep; const char* cB = (const char*)g.Bt + (size_t)cur.pn * tstep;
    S.a_ready(cur);
    if constexpr (Epi::HAS_PREFETCH) E.prefetch(lds, cur, wid, lane, ui);
    if constexpr (SP2) {
        PG8_STAGE(PG8_SB(0, 0), cB, voffB); PG8_STAGE(PG8_SB(0, 1), cB + hstep, voffB); PG8_STAGE(PG8_SA(0, 0), cA, voffA); PG8_STAGE(PG8_SA(0, 1), cA + hstep, voffA);
        if (wr == 1) PG8_BAR;
        PG8_WAIT_V(2); PG8_BAR;
        PG8_STAGE(PG8_SB(1, 0), cB + kstep, voffB); PG8_STAGE(PG8_SA(1, 0), cA + kstep, voffA); PG8_STAGE(PG8_SB(1, 1), cB + hstep + kstep, voffB);
        PG8_WAIT_V(6); PG8_BAR;
    } else {
        PG8_STAGE(PG8_SB(0, 0), cB, voffB); PG8_STAGE(PG8_SA(0, 0), cA, voffA); PG8_STAGE(PG8_SB(0, 1), cB + hstep, voffB); PG8_STAGE(PG8_SA(0, 1), cA + hstep, voffA);
        if (wr == 1) PG8_BAR;
        PG8_WAIT_V(4); PG8_BAR;
        PG8_STAGE(PG8_SB(1, 0), cB + kstep, voffB); PG8_STAGE(PG8_SA(1, 0), cA + kstep, voffA); PG8_STAGE(PG8_SB(1, 1), cB + hstep + kstep, voffB);
        PG8_WAIT_V(6); PG8_BAR;
    }
    for (;;) {
        const bool has_next = S.next(ui + 1, nxt);
        const char* nA = has_next ? (const char*)g.A + (size_t)nxt.pm * tstep : cA; const char* nB = has_next ? (const char*)g.Bt + (size_t)nxt.pn * tstep : cB;
        for (int t = 0; t < nt; t += 2) {
            const bool last = (t == nt - 2);
            const char* a1 = cA + (size_t)(t + 1) * kstep;
            const char* a2 = last ? nA : cA + (size_t)(t + 2) * kstep; const char* b2 = last ? nB : cB + (size_t)(t + 2) * kstep;
            const char* a3 = a2 + kstep; const char* b3 = b2 + kstep;
            if (last && has_next) S.a_ready(nxt);
            if constexpr (SP2) {
            PG8_LDB(B0, 0, 0); PG8_LDB(B1, 0, 1); PG8_SCHED; PG8_LDA(At, 0, 0); PG8_STAGE(PG8_SA(1, 1), a1 + hstep, voffA);
            PG8_WAIT_V(8); PG8_WAIT_L(0); PG8_BAR; PG8_MMA(0, 0, At, B0); PG8_MMA(0, 1, At, B1); PG8_BAR; PG8_SCHED;
            PG8_LDA(At, 0, 1); PG8_STAGE(PG8_SB(0, 0), b2, voffB); PG8_STAGE(PG8_SB(0, 1), b2 + hstep, voffB); PG8_STAGE(PG8_SA(0, 0), a2, voffA);
            PG8_WAIT_V(8); PG8_WAIT_L(0); PG8_BAR; PG8_MMA(1, 0, At, B0); PG8_MMA(1, 1, At, B1); PG8_BAR; PG8_SCHED;
            PG8_LDB(B0, 1, 0); PG8_LDB(B1, 1, 1); PG8_SCHED; PG8_LDA(At, 1, 0); PG8_STAGE(PG8_SA(0, 1), a2 + hstep, voffA);
            PG8_WAIT_V(8); PG8_WAIT_L(0); PG8_BAR; PG8_MMA(0, 0, At, B0); PG8_MMA(0, 1, At, B1); PG8_BAR; PG8_SCHED;
            PG8_LDA(At, 1, 1); PG8_STAGE(PG8_SB(1, 0), b3, voffB); PG8_STAGE(PG8_SB(1, 1), b3 + hstep, voffB); PG8_STAGE(PG8_SA(1, 0), a3, voffA);
            PG8_WAIT_V(8); PG8_WAIT_L(0); PG8_BAR; PG8_MMA(1, 0, At, B0); PG8_MMA(1, 1, At, B1); PG8_BAR; PG8_SCHED;
            } else {
            PG8_LDB(B0, 0, 0); PG8_SCHED; PG8_LDA(At, 0, 0); PG8_STAGE(PG8_SA(1, 1), a1 + hstep, voffA);
            PG8_WAIT_L(8); PG8_BAR; PG8_WAIT_L(0); PG8_MMA(0, 0, At, B0); PG8_BAR; PG8_SCHED;
            PG8_LDB(B1, 0, 1); PG8_STAGE(PG8_SB(0, 0), b2, voffB);
            PG8_BAR; PG8_WAIT_L(0); PG8_MMA(0, 1, At, B1); PG8_BAR;
            PG8_LDA(At, 0, 1); PG8_STAGE(PG8_SA(0, 0), a2, voffA);
            PG8_BAR; PG8_WAIT_L(0); PG8_MMA(1, 0, At, B0); PG8_BAR; PG8_SCHED;
            PG8_STAGE(PG8_SB(0, 1), b2 + hstep, voffB);
            PG8_WAIT_V(6); PG8_BAR; PG8_MMA(1, 1, At, B1); PG8_BAR;
            PG8_LDB(B0, 1, 0); PG8_SCHED; PG8_LDA(At, 1, 0); PG8_STAGE(PG8_SA(0, 1), a2 + hstep, voffA);
            PG8_WAIT_L(8); PG8_BAR; PG8_WAIT_L(0); PG8_MMA(0, 0, At, B0); PG8_BAR; PG8_SCHED;
            PG8_LDB(B1, 1, 1); PG8_STAGE(PG8_SB(1, 0), b3, voffB);
            PG8_BAR; PG8_WAIT_L(0); PG8_MMA(0, 1, At, B1); PG8_BAR;
            PG8_LDA(At, 1, 1); PG8_STAGE(PG8_SA(1, 0), a3, voffA);
            PG8_BAR; PG8_WAIT_L(0); PG8_MMA(1, 0, At, B0); PG8_BAR; PG8_SCHED;
            PG8_STAGE(PG8_SB(1, 1), b3 + hstep, voffB);
            PG8_WAIT_V(6); PG8_BAR; PG8_MMA(1, 1, At, B1); PG8_BAR;
            }
        }
        if constexpr (ALIGN_EPI) { if (wr == 0) PG8_BAR; }
        if constexpr (Epi::HAS_PREFETCH) { E.run(acc, cur, wr, wc, fr, fq, lds, ui); S.done(cur); }
        else if constexpr (!Epi::AFTER_DRAIN) { E(acc, cur, wr, wc, fr, fq); S.done(cur); }
        if (!has_next) break;
#pragma unroll
        for (int a = 0; a < 2; ++a)
#pragma unroll
            for (int b = 0; b < 2; ++b)
#pragma unroll
                for (int m = 0; m < 4; ++m)
#pragma unroll
                    for (int n = 0; n < 2; ++n) acc[a][b][m][n] = (f32x4){0.f, 0.f, 0.f, 0.f};
        cur = nxt; cA = nA; cB = nB; ++ui;
        if constexpr (Epi::HAS_PREFETCH) E.prefetch(lds, cur, wid, lane, ui);
        if constexpr (ALIGN_EPI) { if (wr == 1) PG8_BAR; }
    }
    PG8_WAIT_V(0);
    if constexpr (!ALIGN_EPI) { if (wr == 0) PG8_BAR; }
    PG8_BAR;
    if constexpr (Epi::AFTER_DRAIN) { E.fused(acc, cur, wr, wc, fr, fq, lds, wid, lane); S.done(cur); }
#undef PG8_SA
#undef PG8_SB
#undef PG8_STAGE
#undef PG8_LDA
#undef PG8_LDB
#undef PG8_MMA
#undef PG8_WAIT_V
#undef PG8_WAIT_L
#undef PG8_BAR
#undef PG8_SCHED
}
}

#include <hip/hip_cooperative_groups.h>
namespace cg = cooperative_groups;
#ifndef MK_ONE_LAUNCH
#define MK_ONE_LAUNCH 1
#endif
#ifndef WGM_G1
#define WGM_G1 4
#endif
#ifndef WGM_G2
#define WGM_G2 4
#endif
#ifndef WGM_G3
#define WGM_G3 4
#endif
#ifndef WGM_G4
#define WGM_G4 4
#endif
constexpr int NWAVES = 8, NTHR = 512;
constexpr int NB = 16, SEQ = 4096, D = 1024, M = NB * SEQ, LCTX = 256, MCTX = NB * LCTX, NH = 4, DH = 128, RETW = 512, INW = 2560, DFF = 2816, NUP = 5632, NMOD = 6144;
constexpr float NORM_EPS = 1e-6f;
constexpr size_t MiB = 1u << 20;
constexpr size_t WS_CTL = 0, CTL_ZERO_BYTES = 1 * MiB;
constexpr size_t WS_TG2 = 256 * 1024;
constexpr size_t WS_TM = 384 * 1024;
constexpr size_t WS_MODP = 1 * MiB;
constexpr size_t WS_WIN = 5 * MiB, WS_WOUT = 10 * MiB, WS_WUP = 12 * MiB, WS_WDN = 23 * MiB;
constexpr size_t WS_SCTX = 29 * MiB;
constexpr size_t WS_HCTX = 38 * MiB, WS_CKV = 46 * MiB;
constexpr size_t WS_H = 64 * MiB;
constexpr size_t WS_PROJ = 192 * MiB;
constexpr size_t WS_MIXOUT = 192 * MiB;
constexpr size_t WS_ACT = 544 * MiB;
constexpr size_t WS_FFN = 320 * MiB;
constexpr size_t WS_X1B = 896 * MiB;
constexpr size_t QKVG_T = (size_t)NB * NH * SEQ * DH;
constexpr size_t PROJ_Y = 4 * QKVG_T;
constexpr size_t CKV_T = (size_t)NB * NH * LCTX * DH;
constexpr size_t WS_END = 1024 * MiB;
constexpr int LDS_BYTES = 147456;

#define LAS __attribute__((address_space(3)))
typedef unsigned short bf16;
typedef unsigned v4u __attribute__((ext_vector_type(4)));
typedef unsigned v2u __attribute__((ext_vector_type(2)));
typedef float f32x4 __attribute__((ext_vector_type(4)));
__device__ __forceinline__ unsigned f2bf(float f) { unsigned u = __builtin_bit_cast(unsigned, f); return (u + 0x7fffu + ((u >> 16) & 1u)) >> 16; }
__device__ __forceinline__ unsigned pk2(float lo, float hi) { unsigned r; asm("v_cvt_pk_bf16_f32 %0, %1, %2" : "=v"(r) : "v"(lo), "v"(hi)); return r; }
__device__ __forceinline__ float bf2f(unsigned short b) { return __builtin_bit_cast(float, ((unsigned)b) << 16); }
__device__ __forceinline__ float bflo(unsigned w) { return __builtin_bit_cast(float, w << 16); }
__device__ __forceinline__ float bfhi(unsigned w) { return __builtin_bit_cast(float, w & 0xffff0000u); }
__device__ __forceinline__ float silu_f(float x) { return x / (1.f + __expf(-x)); }
__device__ __forceinline__ float wave_sum(float v) {
#pragma unroll
    for (int o = 1; o < 64; o <<= 1) v += __shfl_xor(v, o);
    return v;
}

struct Args { const float* in[18]; float* out; unsigned char* ws; int ph_lo, ph_hi; };
struct Frame {
    unsigned char* lds; int tid, lane, wave, vcu, G;
    const float *x, *c, *ctx, *c_ctx, *w_ada, *b_ada, *g_mix_pre, *g_mix_post, *g_ffn_pre, *g_ffn_post, *w_in, *dec_f, *dec_b, *w_out, *w_up, *conv_w, *conv_b, *w_down;
    float* out; unsigned char* ws;
};

template <int MODE>
__device__ __forceinline__ void p0_transpose_item(const float* W, int K, int N, int nblk, bf16* WT, float* scr, int item, int lane) {
    const int kb = item / nblk, nb = item % nblk, k0 = 64 * kb, n0 = 32 * nb;
    int sc = n0 + (lane & 31);
    if (MODE == 1 && sc < 1024) { const int lc = sc & 127; sc = (sc & ~127) + 64 * ((lc >> 2) & 1) + 16 * (lc >> 5) + 4 * ((lc >> 3) & 3) + (lc & 3); }
    if (MODE == 2) { const int tcn = sc & 255; sc = (tcn >> 7) * 2816 + 128 * (sc >> 8) + (tcn & 127); }
    float wl[32];
#pragma unroll
    for (int i = 0; i < 32; ++i) { const int kk = 2 * i + (lane >> 5); int kr = k0 + kk;
        if (MODE == 3 && kr >= 512 && (kr & 127) > 64) kr = (kr & ~127) + 192 - (kr & 127);
        wl[i] = W[(size_t)kr * N + sc]; }
#pragma unroll
    for (int i = 0; i < 32; ++i) { const int kk = 2 * i + (lane >> 5); scr[kk * 33 + (lane & 31)] = wl[i]; }
    asm volatile("s_waitcnt lgkmcnt(0)" ::: "memory");
    const int c = lane & 7;
#pragma unroll
    for (int j = 0; j < 4; ++j) { const int n = (lane >> 3) + 8 * j; const float* s = scr + (8 * c) * 33 + n;
        v4u o; o.x = pk2(s[0 * 33], s[1 * 33]); o.y = pk2(s[2 * 33], s[3 * 33]); o.z = pk2(s[4 * 33], s[5 * 33]); o.w = pk2(s[6 * 33], s[7 * 33]);
        *(v4u*)(WT + (size_t)(n0 + n) * K + k0 + 8 * c) = o; }
    asm volatile("s_waitcnt lgkmcnt(0)" ::: "memory");
}

__device__ __forceinline__ void ph_prep_w(Frame& F) {
    __syncthreads();
    float* scr = (float*)(F.lds + F.wave * 16384);
    const int gw = F.vcu * NWAVES + F.wave, NGW = F.G * NWAVES;
    constexpr int I_IN = (D / 64) * (2048 / 32), I_OUT = (D / 64) * (D / 32), I_UP = (D / 64) * (NUP / 32), I_DN = (DFF / 64) * (D / 32);
    for (int it = gw; it < I_IN; it += NGW) p0_transpose_item<1>(F.w_in, D, INW, 64, (bf16*)(F.ws + WS_WIN), scr, it, F.lane);
    __syncthreads();
    {
        float* Wl = (float*)F.lds; float* tc = Wl + 16 * 128; float* ts = tc + 128;
        if (F.tid < 128) { tc[F.tid] = __builtin_amdgcn_cosf((float)F.tid * (1.f / 128.f)); ts[F.tid] = __builtin_amdgcn_sinf((float)F.tid * (1.f / 128.f)); }
        bf16* WT = (bf16*)(F.ws + WS_WIN);
        const float fsc = 0.0013810679320049757f;
        for (int it = blockIdx.x; it < 64 * 4; it += F.G) {
            const int kb = it >> 2, g = it & 3;
            __syncthreads();
            { float wq[4];
#pragma unroll
              for (int q = 0; q < 4; ++q) { const int i = F.tid + NTHR * q; wq[q] = F.w_in[(size_t)(kb * 16 + (i >> 7)) * INW + 2048 + g * 128 + (i & 127)]; }
#pragma unroll
              for (int q = 0; q < 4; ++q) Wl[F.tid + NTHR * q] = wq[q]; }
            __syncthreads();
            const int o = F.tid & 127, kq = F.tid >> 7, p = o >> 1, part = o & 1;
            float a0 = 0.f, a1 = 0.f, a2 = 0.f, a3 = 0.f;
            for (int c = 0; c < 128; ++c) {
                const int ix = (c * p) & 127;
                float cf = part ? -ts[ix] : tc[ix];
                if (p == 0 && part) cf = tc[(64 * c) & 127];
                a0 += Wl[(4 * kq + 0) * 128 + c] * cf; a1 += Wl[(4 * kq + 1) * 128 + c] * cf; a2 += Wl[(4 * kq + 2) * 128 + c] * cf; a3 += Wl[(4 * kq + 3) * 128 + c] * cf;
            }
            v2u w; w.x = pk2(a0 * fsc, a1 * fsc); w.y = pk2(a2 * fsc, a3 * fsc);
            *(v2u*)(WT + (size_t)(2048 + g * 128 + o) * D + kb * 16 + 4 * kq) = w;
        }
    }
    __syncthreads();
}
__device__ __forceinline__ void ph_prep_wrest(Frame& F, int gw, int NGW) {
    __syncthreads();
    float* scr = (float*)(F.lds + F.wave * 16384);
    constexpr int I_OUT = (D / 64) * (D / 32), I_UP = (D / 64) * (NUP / 32), I_DN = (DFF / 64) * (D / 32);
    for (int it = gw; it < I_OUT + I_UP + I_DN; it += NGW) {
        int r = it;
        if (r < I_OUT) { p0_transpose_item<3>(F.w_out, D, D, D / 32, (bf16*)(F.ws + WS_WOUT), scr, r, F.lane); continue; } r -= I_OUT;
        if (r < I_UP) { p0_transpose_item<2>(F.w_up, D, NUP, NUP / 32, (bf16*)(F.ws + WS_WUP), scr, r, F.lane); continue; } r -= I_UP;
        p0_transpose_item<0>(F.w_down, DFF, D, D / 32, (bf16*)(F.ws + WS_WDN), scr, r, F.lane);
    }
    __syncthreads();
}
__device__ __forceinline__ void ph_prep_ada(Frame& F) {
    __syncthreads();
    float* sil = (float*)F.lds;
    float* red = (float*)(F.lds + 16384);
    float* modp = (float*)(F.ws + WS_MODP);
    for (int it = blockIdx.x; it < 24 * 8; it += F.G) {
        const int jc = it % 24, kc = it / 24;
        const int col = jc * 256 + (F.tid & 255), kh = F.tid >> 8;
        float wv[64];
#pragma unroll
        for (int j = 0; j < 64; ++j) wv[j] = F.w_ada[(size_t)(kc * 128 + kh * 64 + j) * NMOD + col];
        { float cv[5];
#pragma unroll
          for (int q = 0; q < 5; ++q) { const int i = F.tid + NTHR * q, r = i >> 7, kk = i & 127; cv[q] = (i < 17 * 128) ? ((r < 16) ? F.c[r * D + kc * 128 + kk] : F.c_ctx[kc * 128 + kk]) : 0.f; }
#pragma unroll
          for (int q = 0; q < 5; ++q) { const int i = F.tid + NTHR * q; if (i < 17 * 128) sil[i] = silu_f(cv[q]); } }
        __syncthreads();
        float acc[17];
#pragma unroll
        for (int r = 0; r < 17; ++r) acc[r] = 0.f;
#pragma unroll
        for (int j = 0; j < 64; ++j) { const float w = wv[j];
#pragma unroll
            for (int r = 0; r < 17; ++r) acc[r] += sil[r * 128 + kh * 64 + j] * w; }
        if (kh == 1) {
#pragma unroll
            for (int r = 0; r < 17; ++r) red[r * 256 + (F.tid & 255)] = acc[r]; }
        __syncthreads();
        if (kh == 0) {
#pragma unroll
            for (int r = 0; r < 17; ++r) modp[(size_t)(kc * 17 + r) * NMOD + col] = acc[r] + red[r * 256 + (F.tid & 255)]; }
        __syncthreads();
    }
}
__device__ __forceinline__ float mod_val(const Frame& F, int mr, int ch, int col) {
    const float* modp = (const float*)(F.ws + WS_MODP); const int j = ch * D + col; float s = F.b_ada[j];
#pragma unroll
    for (int kc = 0; kc < 8; ++kc) s += modp[(size_t)(kc * 17 + mr) * NMOD + j];
    return s;
}
__device__ __forceinline__ void ph_norm1(Frame& F) {
    float* vA = (float*)F.lds; float* vB = vA + D; float* vAc = vB + D; float* vBc = vAc + D;
    for (int grp = blockIdx.x; grp < M / 256; grp += F.G) {
        const int mr = grp / 16;
        __syncthreads();
        for (int col = F.tid; col < D; col += NTHR) { const float gp = F.g_mix_pre[col];
            vA[col] = gp * (1.f + mod_val(F, mr, 1, col)); vB[col] = mod_val(F, mr, 0, col);
            vAc[col] = gp * (1.f + mod_val(F, 16, 1, col)); vBc[col] = mod_val(F, 16, 0, col); }
        __syncthreads();
        for (int r = 2 * F.wave; r < 256 + 16; r += 2 * NWAVES) {
            const bool is_ctx = r >= 256;
            const float* src = is_ctx ? F.ctx + ((size_t)grp * 16 + (r - 256)) * D : F.x + ((size_t)grp * 256 + r) * D;
            bf16* dst = is_ctx ? (bf16*)(F.ws + WS_HCTX) + ((size_t)grp * 16 + (r - 256)) * D : (bf16*)(F.ws + WS_H) + ((size_t)grp * 256 + r) * D;
            const float* pa = is_ctx ? vAc : vA; const float* pb = is_ctx ? vBc : vB;
            f32x4 v[2][4]; float ss[2];
#pragma unroll
            for (int q = 0; q < 2; ++q) { const f32x4* xr = (const f32x4*)(src + (size_t)q * D) + F.lane;
#pragma unroll
                for (int j = 0; j < 4; ++j) v[q][j] = xr[64 * j]; }
#pragma unroll
            for (int q = 0; q < 2; ++q) { ss[q] = 0.f;
#pragma unroll
                for (int j = 0; j < 4; ++j) ss[q] += (v[q][j].x * v[q][j].x + v[q][j].y * v[q][j].y) + (v[q][j].z * v[q][j].z + v[q][j].w * v[q][j].w); }
#pragma unroll
            for (int q = 0; q < 2; ++q) { const float rstd = rsqrtf(wave_sum(ss[q]) * (1.f / D) + NORM_EPS);
                unsigned long long* o8 = (unsigned long long*)(dst + (size_t)q * D) + F.lane;
#pragma unroll
                for (int j = 0; j < 4; ++j) { const int c0 = 4 * F.lane + 256 * j; const f32x4 a = *(const f32x4*)(pa + c0), b = *(const f32x4*)(pb + c0);
                    const f32x4 h = v[q][j] * rstd * a + b;
                    o8[64 * j] = (unsigned long long)pk2(h.x, h.y) | ((unsigned long long)pk2(h.z, h.w) << 32); } }
        }
    }
}
__device__ __forceinline__ float log_gamma(const float* dec, int h) { const float xv = dec[h]; return -log1pf(expf(-xv)); }
constexpr size_t WS_ST = 512 * MiB;
typedef short s16x4 __attribute__((ext_vector_type(4)));
typedef short bf16x8 __attribute__((ext_vector_type(8)));
#define RET_KP 272
#define RET_VP 144
__device__ __forceinline__ bf16x8 tr2(LAS unsigned char* a0, LAS unsigned char* a1) {
    const s16x4 lo = __builtin_amdgcn_ds_read_tr16_b64_v4i16((LAS s16x4*)a0), hi = __builtin_amdgcn_ds_read_tr16_b64_v4i16((LAS s16x4*)a1);
    return __builtin_shufflevector(lo, hi, 0, 1, 2, 3, 4, 5, 6, 7);
}
__device__ __forceinline__ v4u scale8(v4u w, float z) {
    v4u o;
#pragma unroll
    for (int j = 0; j < 4; ++j) o[j] = pk2(bflo(w[j]) * z, bfhi(w[j]) * z);
    return o;
}
__device__ __forceinline__ int r1_sw(int row) { return ((row & 3) << 1) | (((row >> 3) & 1) << 3); }
__device__ __forceinline__ void ph_ret_states(Frame& F, LAS unsigned char* L, int ch) {
    const bf16* proj = (const bf16*)(F.ws + WS_PROJ); const bf16* ckv = (const bf16*)(F.ws + WS_CKV); bf16* ST = (bf16*)(F.ws + WS_ST);
    const int w = F.wave, l = F.lane, fq = l >> 4, g = l >> 4, q = (l & 15) >> 2, p = l & 3, wd = w >> 2, we = w & 3;
    constexpr int TILEB = 128 * 256, BUFB = 2 * TILEB;
    {
        const int dir = ch & 1, h = (ch >> 1) & 3, b = ch >> 3;
        const float l2 = log_gamma(dir ? F.dec_b : F.dec_f, h) * 1.4426950408889634f;
        const float cd = exp2f(128.f * l2);
        float zv[4]; int woff[4];
#pragma unroll
        for (int i = 0; i < 4; ++i) { const int qi = F.tid + 512 * i, c = qi >> 4; zv[i] = exp2f((float)(dir ? c : 127 - c) * l2); woff[i] = c * 256 + (((qi & 15) ^ r1_sw(c)) << 4); }
        const int trow = 8 * g + q, tsw = r1_sw(trow);
        int aoff[4], boff[2];
#pragma unroll
        for (int mf = 0; mf < 4; ++mf) aoff[mf] = trow * 256 + ((((8 * wd + 2 * mf) + (p >> 1)) ^ tsw) << 4) + (p & 1) * 8;
#pragma unroll
        for (int nf = 0; nf < 2; ++nf) boff[nf] = trow * 256 + ((((4 * we + 2 * nf) + (p >> 1)) ^ tsw) << 4) + (p & 1) * 8;
        pg8::f32x4 acc[4][2];
#pragma unroll
        for (int mf = 0; mf < 4; ++mf)
#pragma unroll
            for (int nf = 0; nf < 2; ++nf) acc[mf][nf] = (pg8::f32x4){0.f, 0.f, 0.f, 0.f};
        v4u kA[4], vA[4], kB[4], vB[4];
        __syncthreads();
#define R1_SRC(s, kp, vp) do { if ((s) < 2) { const int cchunk = dir ? 1 - (s) : (s); kp = ckv + ((size_t)(b * NH + h) * LCTX + cchunk * 128) * DH; vp = kp + CKV_T; } \
            else { const int n_ = dir ? 31 - ((s) - 2) : (s) - 2; kp = proj + QKVG_T + ((size_t)(b * NH + h) * SEQ + n_ * 128) * DH; vp = kp + QKVG_T; } } while (0)
#define R1_ISSUE(s, kr, vr) do { const bf16* kp_; const bf16* vp_; R1_SRC(s, kp_, vp_); \
            _Pragma("unroll") for (int i = 0; i < 4; ++i) { const int qi = F.tid + 512 * i; kr[i] = *(const v4u*)(kp_ + qi * 8); vr[i] = *(const v4u*)(vp_ + qi * 8); } } while (0)
#define R1_WRITE(s, buf, kr, vr) do { LAS unsigned char* kb_ = L + (buf) * BUFB; LAS unsigned char* vb_ = kb_ + TILEB; \
            _Pragma("unroll") for (int i = 0; i < 4; ++i) { *(LAS v4u*)(kb_ + woff[i]) = kr[i]; *(LAS v4u*)(vb_ + woff[i]) = scale8(vr[i], zv[i]); } } while (0)
#define R1_STEP(s, buf, ST_) do { \
            if (ST_) { const int n = dir ? 31 - ((s) - 2) : (s) - 2; \
                bf16* sp = ST + ((size_t)(((b * NH + h) * 2 + dir) * 32 + n) << 14) + (size_t)(32 * we + (l & 15)) * DH + 64 * wd + 4 * fq; \
                _Pragma("unroll") for (int mf = 0; mf < 4; ++mf) _Pragma("unroll") for (int nf = 0; nf < 2; ++nf) { v2u o; o.x = pk2(acc[mf][nf][0], acc[mf][nf][1]); o.y = pk2(acc[mf][nf][2], acc[mf][nf][3]); *(v2u*)(sp + nf * 16 * DH + mf * 16) = o; } } \
            _Pragma("unroll") for (int mf = 0; mf < 4; ++mf) _Pragma("unroll") for (int nf = 0; nf < 2; ++nf) acc[mf][nf] = acc[mf][nf] * cd; \
            LAS unsigned char* kb = L + (buf) * BUFB; LAS unsigned char* vb = kb + TILEB; \
            _Pragma("unroll") for (int ks = 0; ks < 4; ++ks) { bf16x8 Bv[2]; \
                _Pragma("unroll") for (int nf = 0; nf < 2; ++nf) { LAS unsigned char* va = vb + boff[nf] + ks * 32 * 256; Bv[nf] = tr2(va, va + 4 * 256); } \
                _Pragma("unroll") for (int mf = 0; mf < 4; ++mf) { LAS unsigned char* ka = kb + aoff[mf] + ks * 32 * 256; const bf16x8 A = tr2(ka, ka + 4 * 256); \
                    _Pragma("unroll") for (int nf = 0; nf < 2; ++nf) acc[mf][nf] = __builtin_amdgcn_mfma_f32_16x16x32_bf16(A, Bv[nf], acc[mf][nf], 0, 0, 0); } } } while (0)
        R1_ISSUE(0, kA, vA); R1_WRITE(0, 0, kA, vA);
        __syncthreads();
        R1_ISSUE(1, kA, vA); R1_ISSUE(2, kB, vB);
        R1_STEP(0, 0, false); R1_WRITE(1, 1, kA, vA); __syncthreads(); R1_ISSUE(3, kA, vA);
        R1_STEP(1, 1, false); R1_WRITE(2, 0, kB, vB); __syncthreads(); R1_ISSUE(4, kB, vB);
#pragma unroll 1
        for (int s = 2; s < 34; s += 2) {
            const int s3 = (s + 3 < 34) ? s + 3 : 33, s4 = (s + 4 < 34) ? s + 4 : 33;
            R1_STEP(s, 0, true);
            R1_WRITE(s + 1, 1, kA, vA);
            __syncthreads();
            R1_ISSUE(s3, kA, vA);
            R1_STEP(s + 1, 1, true);
            R1_WRITE(s + 2, 0, kB, vB);
            __syncthreads();
            R1_ISSUE(s4, kB, vB);
        }
#undef R1_SRC
#undef R1_ISSUE
#undef R1_WRITE
#undef R1_STEP
    }
}
__device__ __forceinline__ void ph_ret_states_rs(Frame& F, LAS unsigned char* L, int ch) {
    const bf16* proj = (const bf16*)(F.ws + WS_PROJ); const bf16* ckv = (const bf16*)(F.ws + WS_CKV); bf16* ST = (bf16*)(F.ws + WS_ST);
    const int w = F.wave, l = F.lane;
    constexpr int TILEB = 128 * 256, BUFB = 2 * TILEB;
    const int dir = ch & 1, h = (ch >> 1) & 3, b = ch >> 3;
    const float l2 = log_gamma(dir ? F.dec_b : F.dec_f, h) * 1.4426950408889634f;
    __syncthreads();
#define RS_SRC(s, kp, vp) do { if ((s) < 2) { const int cchunk = dir ? 1 - (s) : (s); kp = ckv + ((size_t)(b * NH + h) * LCTX + cchunk * 128) * DH; vp = kp + CKV_T; } \
        else { const int n_ = dir ? 31 - ((s) - 2) : (s) - 2; kp = proj + QKVG_T + ((size_t)(b * NH + h) * SEQ + n_ * 128) * DH; vp = kp + QKVG_T; } } while (0)
    if (w < 4) {
        const int lt = F.tid;
        float zv[8]; int woff[8];
#pragma unroll
        for (int i = 0; i < 8; ++i) { const int qi = lt + 256 * i, c = qi >> 4; zv[i] = exp2f((float)(dir ? c : 127 - c) * l2); woff[i] = c * 256 + (((qi & 15) ^ r1_sw(c)) << 4); }
        v4u kA[8], vA[8], kB[8], vB[8];
#define RS_ISSUE(s, kr, vr) do { const bf16* kp_; const bf16* vp_; RS_SRC(s, kp_, vp_); \
            _Pragma("unroll") for (int i = 0; i < 8; ++i) { const int qi = lt + 256 * i; kr[i] = *(const v4u*)(kp_ + qi * 8); vr[i] = *(const v4u*)(vp_ + qi * 8); } } while (0)
#define RS_WRITE(buf, kr, vr) do { LAS unsigned char* kb_ = L + (buf) * BUFB; LAS unsigned char* vb_ = kb_ + TILEB; \
            _Pragma("unroll") for (int i = 0; i < 8; ++i) { *(LAS v4u*)(kb_ + woff[i]) = kr[i]; *(LAS v4u*)(vb_ + woff[i]) = scale8(vr[i], zv[i]); } } while (0)
        RS_ISSUE(0, kA, vA); RS_WRITE(0, kA, vA);
        __syncthreads();
        RS_ISSUE(1, kA, vA); RS_ISSUE(2, kB, vB);
#pragma unroll 1
        for (int s = 0; s < 34; s += 2) {
            const int s3 = (s + 3 < 34) ? s + 3 : 33, s4 = (s + 4 < 34) ? s + 4 : 33;
            RS_WRITE(1, kA, vA); __syncthreads(); RS_ISSUE(s3, kA, vA);
            RS_WRITE(0, kB, vB); __syncthreads(); RS_ISSUE(s4, kB, vB);
        }
#undef RS_ISSUE
#undef RS_WRITE
    } else {
        const int cw = w - 4, wd = cw >> 1, we = cw & 1, fq = l >> 4, g = l >> 4, q = (l & 15) >> 2, p = l & 3;
        const float cd = exp2f(128.f * l2);
        const int trow = 8 * g + q, tsw = r1_sw(trow);
        int aoff[4], boff[4];
#pragma unroll
        for (int mf = 0; mf < 4; ++mf) { aoff[mf] = trow * 256 + ((((8 * wd + 2 * mf) + (p >> 1)) ^ tsw) << 4) + (p & 1) * 8; boff[mf] = trow * 256 + ((((8 * we + 2 * mf) + (p >> 1)) ^ tsw) << 4) + (p & 1) * 8; }
        pg8::f32x4 acc[4][4];
#pragma unroll
        for (int mf = 0; mf < 4; ++mf)
#pragma unroll
            for (int nf = 0; nf < 4; ++nf) acc[mf][nf] = (pg8::f32x4){0.f, 0.f, 0.f, 0.f};
#define RS_STEP(s, buf, ST_) do { \
            if (ST_) { const int n = dir ? 31 - ((s) - 2) : (s) - 2; \
                bf16* sp = ST + ((size_t)(((b * NH + h) * 2 + dir) * 32 + n) << 14) + (size_t)(64 * we + (l & 15)) * DH + 64 * wd + 4 * fq; \
                _Pragma("unroll") for (int mf = 0; mf < 4; ++mf) _Pragma("unroll") for (int nf = 0; nf < 4; ++nf) { v2u o; o.x = pk2(acc[mf][nf][0], acc[mf][nf][1]); o.y = pk2(acc[mf][nf][2], acc[mf][nf][3]); *(v2u*)(sp + nf * 16 * DH + mf * 16) = o; } } \
            _Pragma("unroll") for (int mf = 0; mf < 4; ++mf) _Pragma("unroll") for (int nf = 0; nf < 4; ++nf) acc[mf][nf] = acc[mf][nf] * cd; \
            LAS unsigned char* kb = L + (buf) * BUFB; LAS unsigned char* vb = kb + TILEB; \
            _Pragma("unroll") for (int ks = 0; ks < 4; ++ks) { bf16x8 Bv[4]; \
                _Pragma("unroll") for (int nf = 0; nf < 4; ++nf) { LAS unsigned char* va = vb + boff[nf] + ks * 32 * 256; Bv[nf] = tr2(va, va + 4 * 256); } \
                _Pragma("unroll") for (int mf = 0; mf < 4; ++mf) { LAS unsigned char* ka = kb + aoff[mf] + ks * 32 * 256; const bf16x8 A = tr2(ka, ka + 4 * 256); \
                    _Pragma("unroll") for (int nf = 0; nf < 4; ++nf) acc[mf][nf] = __builtin_amdgcn_mfma_f32_16x16x32_bf16(A, Bv[nf], acc[mf][nf], 0, 0, 0); } } } while (0)
        __syncthreads();
        RS_STEP(0, 0, false); __syncthreads();
        RS_STEP(1, 1, false); __syncthreads();
#pragma unroll 1
        for (int s = 2; s < 34; s += 2) {
            RS_STEP(s, 0, true); __syncthreads();
            RS_STEP(s + 1, 1, true); __syncthreads();
        }
#undef RS_STEP
    }
#undef RS_SRC
}
__device__ __forceinline__ void ph_ret_out(Frame& F, LAS unsigned char* L) {
    const __amdgpu_buffer_rsrc_t rp = __builtin_amdgcn_make_buffer_rsrc((void*)(F.ws + WS_PROJ), (short)0, (int)((size_t)M * INW * 2), 0x00020000);
    const __amdgpu_buffer_rsrc_t rs = __builtin_amdgcn_make_buffer_rsrc((void*)(F.ws + WS_ST), (short)0, (int)((size_t)NB * NH * 2 * 32 * 16384 * 2), 0x00020000);
    const __amdgpu_buffer_rsrc_t rm = __builtin_amdgcn_make_buffer_rsrc((void*)(F.ws + WS_H), (short)0, (int)((size_t)M * D * 2), 0x00020000);
    const int w = F.wave, l = F.lane, fq = l >> 4, g = l >> 4, q = (l & 15) >> 2, p = l & 3, li = l & 15;
    constexpr int TB = 128 * RET_KP;
    LAS unsigned char* Kt = L; LAS unsigned char* Vt = L + TB; LAS unsigned char* Tf = L + 2 * TB; LAS unsigned char* Tb = L + 3 * TB;
    const int iloc = 16 * w + li;
    v4u r0[4], r1[4];
    int vkv[4], vst[4];
#pragma unroll
    for (int i = 0; i < 4; ++i) { const int qi = F.tid + 512 * i; vkv[i] = qi * 16; vst[i] = qi * 16; }
    const int vq = (iloc * DH + 8 * fq) * 2, vg = (iloc * DH + 4 * fq) * 2, vo = (iloc * D + 4 * fq) * 2;
#define R2_ISSUE_KV(it) do { const int n_ = (it) & 31, h_ = ((it) >> 5) & 3, b_ = (it) >> 7; const int s0_ = (((b_ * NH + h_) * SEQ + n_ * 128) * DH) * 2; \
        _Pragma("unroll") for (int i = 0; i < 4; ++i) { r0[i] = __builtin_amdgcn_raw_buffer_load_b128(rp, vkv[i], s0_ + (int)(QKVG_T * 2), 0); r1[i] = __builtin_amdgcn_raw_buffer_load_b128(rp, vkv[i], s0_ + (int)(2 * QKVG_T * 2), 0); } } while (0)
#define R2_ISSUE_Q(it, dst) do { const int n_ = (it) & 31, h_ = ((it) >> 5) & 3, b_ = (it) >> 7; const int s0_ = (((b_ * NH + h_) * SEQ + n_ * 128) * DH) * 2; \
        _Pragma("unroll") for (int ks = 0; ks < 4; ++ks) dst[ks] = __builtin_amdgcn_raw_buffer_load_b128(rp, vq + ks * 64, s0_, 0); } while (0)
    v4u Qn[4];
    if ((int)blockIdx.x < NB * NH * 32) { R2_ISSUE_KV((int)blockIdx.x); R2_ISSUE_Q((int)blockIdx.x, Qn); }
    for (int item = blockIdx.x; item < NB * NH * 32; item += F.G) {
        const int n = item & 31, h = (item >> 5) & 3, b = item >> 7;
        const size_t tok0 = (size_t)b * SEQ + n * 128;
        int ilo = iloc; asm volatile("" : "+v"(ilo));
        const float l2f = log_gamma(F.dec_f, h) * 1.4426950408889634f, l2b = log_gamma(F.dec_b, h) * 1.4426950408889634f;
        bf16x8 Qf[4];
#pragma unroll
        for (int ks = 0; ks < 4; ++ks) Qf[ks] = __builtin_bit_cast(bf16x8, Qn[ks]);
#pragma unroll
        for (int i = 0; i < 4; ++i) { const int qi = F.tid + 512 * i, off = (qi >> 4) * RET_KP + (qi & 15) * 16; *(LAS v4u*)(Kt + off) = r0[i]; *(LAS v4u*)(Vt + off) = r1[i]; }
        __syncthreads();
        v4u r2[4], r3[4];
        { const int sf = ((((b * NH + h) * 2 + 0) * 32 + n) << 15), sb = ((((b * NH + h) * 2 + 1) * 32 + n) << 15);
#pragma unroll
          for (int i = 0; i < 4; ++i) { r2[i] = __builtin_amdgcn_raw_buffer_load_b128(rs, vst[i], sf, 0); r3[i] = __builtin_amdgcn_raw_buffer_load_b128(rs, vst[i], sb, 0); } }
        bf16x8 Pk[4];
#pragma unroll
        for (int hv = 0; hv < 2; ++hv) {
            pg8::f32x4 st[4];
#pragma unroll
            for (int m4 = 0; m4 < 4; ++m4) { const int mf = 4 * hv + m4; st[m4] = (pg8::f32x4){0.f, 0.f, 0.f, 0.f};
#pragma unroll
                for (int ks = 0; ks < 4; ++ks) { const bf16x8 A = *(const LAS bf16x8*)(Kt + (16 * mf + li) * RET_KP + (32 * ks + 8 * fq) * 2);
                    st[m4] = __builtin_amdgcn_mfma_f32_16x16x32_bf16(A, Qf[ks], st[m4], 0, 0, 0); } }
#pragma unroll
            for (int s2 = 0; s2 < 2; ++s2) { const int s = 2 * hv + s2; float v[8];
#pragma unroll
                for (int hh = 0; hh < 2; ++hh)
#pragma unroll
                    for (int r = 0; r < 4; ++r) { const int j = 32 * s + 16 * hh + 4 * fq + r; const int dd = ilo - j;
                        const float dm = exp2f(dd >= 0 ? (float)dd * l2f : (float)(-dd) * l2b); v[4 * hh + r] = st[2 * s2 + hh][r] * dm; }
                v4u pkd; pkd.x = pk2(v[0], v[1]); pkd.y = pk2(v[2], v[3]); pkd.z = pk2(v[4], v[5]); pkd.w = pk2(v[6], v[7]);
                Pk[s] = __builtin_bit_cast(bf16x8, pkd); }
            asm volatile("" ::: "memory");
        }
        pg8::f32x4 ot[8];
#pragma unroll
        for (int mf = 0; mf < 8; ++mf) { pg8::f32x4 o = (pg8::f32x4){0.f, 0.f, 0.f, 0.f};
#pragma unroll
            for (int s = 0; s < 4; ++s) { LAS unsigned char* va = Vt + (32 * s + 4 * g + q) * RET_KP + (16 * mf + 4 * p) * 2;
                const bf16x8 A = tr2(va, va + 16 * RET_KP);
                o = __builtin_amdgcn_mfma_f32_16x16x32_bf16(A, Pk[s], o, 0, 0, 0); }
            ot[mf] = o; }
#pragma unroll
        for (int i = 0; i < 4; ++i) { const int qi = F.tid + 512 * i, off = (qi >> 4) * RET_KP + (qi & 15) * 16; *(LAS v4u*)(Tf + off) = r2[i]; *(LAS v4u*)(Tb + off) = r3[i]; }
        __syncthreads();
        if (item + F.G < NB * NH * 32) { R2_ISSUE_KV(item + F.G); R2_ISSUE_Q(item + F.G, Qn); }
        const float xf = exp2f((float)(iloc + 1) * l2f), xb = exp2f((float)(128 - iloc) * l2b);
        const int sg = (((b * NH + h) * SEQ + n * 128) * DH) * 2 + (int)(3 * QKVG_T * 2), so = (int)((tok0 * D + h * DH) * 2);
        v2u gw[8];
#pragma unroll
        for (int mf = 0; mf < 8; ++mf) gw[mf] = __builtin_amdgcn_raw_buffer_load_b64(rp, vg + 32 * mf, sg, 0);
        float ss = 0.f;
#pragma unroll
        for (int mf = 0; mf < 8; ++mf) {
            pg8::f32x4 c1 = (pg8::f32x4){0.f, 0.f, 0.f, 0.f}, c2 = c1;
#pragma unroll
            for (int ks = 0; ks < 4; ++ks) { const bf16x8 Af = *(const LAS bf16x8*)(Tf + (16 * mf + li) * RET_KP + (32 * ks + 8 * fq) * 2);
                const bf16x8 Ab = *(const LAS bf16x8*)(Tb + (16 * mf + li) * RET_KP + (32 * ks + 8 * fq) * 2);
                c1 = __builtin_amdgcn_mfma_f32_16x16x32_bf16(Af, Qf[ks], c1, 0, 0, 0);
                c2 = __builtin_amdgcn_mfma_f32_16x16x32_bf16(Ab, Qf[ks], c2, 0, 0, 0); }
            const pg8::f32x4 o = ot[mf] + c1 * xf + c2 * xb; ot[mf] = o; ss += (o[0] * o[0] + o[1] * o[1]) + (o[2] * o[2] + o[3] * o[3]);
        }
        ss += __shfl_xor(ss, 16); ss += __shfl_xor(ss, 32);
        const float rstd = rsqrtf(ss * (1.f / DH) + NORM_EPS);
#pragma unroll
        for (int mf = 0; mf < 8; ++mf) { const v2u gv = gw[mf];
            v2u o; o.x = pk2(ot[mf][0] * rstd * silu_f(bflo(gv.x)), ot[mf][1] * rstd * silu_f(bfhi(gv.x))); o.y = pk2(ot[mf][2] * rstd * silu_f(bflo(gv.y)), ot[mf][3] * rstd * silu_f(bfhi(gv.y)));
            __builtin_amdgcn_raw_buffer_store_b64(o, rm, vo + 32 * mf, so, 0); }
    }
#undef R2_ISSUE_KV
#undef R2_ISSUE_Q
}
typedef float cf2 __attribute__((ext_vector_type(2)));
__device__ __forceinline__ cf2 cmul(cf2 a, cf2 b) { return cf2{a.x * b.x - a.y * b.y, a.x * b.y + a.y * b.x}; }
template <int CTRL> __device__ __forceinline__ float qperm(float x) { return __int_as_float(__builtin_amdgcn_update_dpp(0, __float_as_int(x), CTRL, 0xf, 0xf, false)); }
__device__ __forceinline__ cf2 cswapneg(cf2 a) { return cf2{a.y, -a.x}; }
__device__ __forceinline__ cf2 cmulv(cf2 a, cf2 w, cf2 wr) { return __builtin_elementwise_fma(cf2{a.y, a.y}, wr, cf2{a.x, a.x} * w); }
__device__ __forceinline__ void dft4v(cf2& a0, cf2& a1, cf2& a2, cf2& a3) {
    const cf2 s02 = a0 + a2, d02 = a0 - a2, s13 = a1 + a3, d13 = a1 - a3, r = cswapneg(d13);
    a0 = s02 + s13; a2 = s02 - s13; a1 = d02 + r; a3 = d02 - r;
}
__device__ __forceinline__ void fft16v(cf2 (&v)[16]) {
#pragma unroll
    for (int m0 = 0; m0 < 4; ++m0) dft4v(v[m0], v[4 + m0], v[8 + m0], v[12 + m0]);
    constexpr float C1 = 0.92387953251128674f, S1 = 0.38268343236508977f, C2 = 0.70710678118654752f;
#define FT16(i, wc_, ws_) v[i] = cmulv(v[i], cf2{wc_, ws_}, cf2{-(ws_), wc_})
    FT16(5, C1, -S1); FT16(6, C2, -C2); FT16(7, S1, -C1);
    FT16(9, C2, -C2); v[10] = cswapneg(v[10]); FT16(11, -C2, -C2);
    FT16(13, S1, -C1); FT16(14, -C2, -C2); FT16(15, -C1, S1);
#undef FT16
#pragma unroll
    for (int q = 0; q < 4; ++q) dft4v(v[4 * q], v[4 * q + 1], v[4 * q + 2], v[4 * q + 3]);
}
struct QuadCtx { cf2 tw[16]; cf2 sg, kA, kB; };
__device__ __forceinline__ void quad_ctx(QuadCtx& Q, int n0) {
    const float n0r = (float)n0 * (1.f / 64.f);
#pragma unroll
    for (int s = 1; s < 16; ++s) { const int q = (s >> 2) + 4 * (s & 3); const float ang = n0r * (float)q; Q.tw[s] = cf2{__builtin_amdgcn_cosf(ang), -__builtin_amdgcn_sinf(ang)}; }
    const float sg = (n0 & 2) ? -1.f : 1.f; Q.sg = cf2{sg, sg};
    Q.kA = (n0 == 0) ? cf2{1.f, 1.f} : (n0 == 2) ? cf2{-1.f, -1.f} : cf2{0.f, 0.f};
    Q.kB = (n0 == 1) ? cf2{1.f, -1.f} : (n0 == 3) ? cf2{-1.f, 1.f} : cf2{0.f, 0.f};
}
template <int CTRL> __device__ __forceinline__ cf2 qperm2(cf2 v) { return cf2{qperm<CTRL>(v.x), qperm<CTRL>(v.y)}; }
__device__ __forceinline__ void fft64_quadv(cf2 (&a)[16], const QuadCtx& Q) {
    fft16v(a);
#pragma unroll
    for (int s = 1; s < 16; ++s) a[s] = cmulv(a[s], Q.tw[s], cf2{-Q.tw[s].y, Q.tw[s].x});
#pragma unroll
    for (int s = 0; s < 16; ++s) {
        const cf2 t = __builtin_elementwise_fma(a[s], Q.sg, qperm2<0x4E>(a[s]));
        const cf2 E = qperm2<0x88>(t), O = qperm2<0xDD>(t);
        a[s] = __builtin_elementwise_fma(cf2{O.y, O.x}, Q.kB, __builtin_elementwise_fma(O, Q.kA, E));
    }
}
__device__ __forceinline__ int fft_row(int l1, int l2) { return 64 * l1 + ((l2 + 2 * (l1 & 3)) & 63); }
__device__ __forceinline__ void ph_fft2(Frame& F, LAS unsigned char* L, int first, int stride) {
    const __amdgpu_buffer_rsrc_t ry = __builtin_amdgcn_make_buffer_rsrc((void*)(F.ws + WS_PROJ + PROJ_Y * 2), (short)0, (int)((size_t)M * 512 * 2), 0x00020000);
    const __amdgpu_buffer_rsrc_t rm = __builtin_amdgcn_make_buffer_rsrc((void*)(F.ws + WS_H), (short)0, (int)((size_t)M * D * 2), 0x00020000);
    LAS unsigned char* IM = L + 131072;
    const int n0 = F.tid & 3, quad = F.tid >> 2, c = quad & 7, qh = quad >> 3;
    QuadCtx Q; quad_ctx(Q, n0);
#define FFT_ITEM(i0_) ((stride == 128) ? (((first & 7) + 8 * (((first >> 3) >> 3) + 2 * ((i0_) >> 7))) * 8 + ((first >> 3) & 7)) : (i0_))
    v4u w[16];
    { const int itf = FFT_ITEM((first < NB * 4 * 8) ? first : 0);
#pragma unroll
      for (int i = 0; i < 16; ++i) w[i] = __builtin_amdgcn_raw_buffer_load_b128(ry, (F.tid + 512 * i) * 16, itf * 131072, 0); }
    for (int it0 = first; it0 < NB * 4 * 8; it0 += stride) {
        const int it = FFT_ITEM(it0);
        const int cb = it & 7, bg = it >> 3, b = bg >> 2, g = bg & 3;
        __syncthreads();
#pragma unroll
        for (int i = 0; i < 16; ++i) { const int q = F.tid + 512 * i, tok = q >> 1; *(LAS v4u*)(L + fft_row(tok >> 6, tok & 63) * 32 + (q & 1) * 16) = w[i]; }
        __syncthreads();
#pragma unroll 1
        for (int ps = 0; ps < 4; ++ps) { const int l2 = 16 * ps + qh; int n0o = n0; asm volatile("" : "+v"(n0o));
            cf2 a[16];
#pragma unroll
            for (int n1 = 0; n1 < 16; ++n1) { const unsigned w = *(const LAS unsigned*)(L + fft_row(4 * n1 + n0o, l2) * 32 + c * 4); a[n1] = cf2{bflo(w), bfhi(w)}; }
            fft64_quadv(a, Q);
            const float l2r = (float)l2 * (1.f / 4096.f);
#pragma unroll
            for (int s = 0; s < 16; ++s) { const int q = (s >> 2) + 4 * (s & 3), l1p = q + 16 * n0o; const float ang = l2r * (float)l1p;
                const cf2 o = cmul(a[s], cf2{__builtin_amdgcn_cosf(ang), -__builtin_amdgcn_sinf(ang)});
                *(LAS unsigned*)(L + fft_row(l1p, l2) * 32 + c * 4) = pk2(o.x, o.y); } }
        __syncthreads();
#pragma unroll 1
        for (int ps = 0; ps < 4; ++ps) { const int l1p = 16 * ps + qh; int n0o = n0; asm volatile("" : "+v"(n0o));
            cf2 a[16];
#pragma unroll
            for (int n1 = 0; n1 < 16; ++n1) { const unsigned w = *(const LAS unsigned*)(L + fft_row(l1p, 4 * n1 + n0o) * 32 + c * 4); a[n1] = cf2{bflo(w), bfhi(w)}; }
            fft64_quadv(a, Q);
#pragma unroll
            for (int s = 0; s < 16; ++s) { const int q = (s >> 2) + 4 * (s & 3), k = q + 16 * n0o;
                *(LAS float*)(L + fft_row(l1p, k) * 32 + c * 4) = a[s].x;
                if (cb == 0 && c == 0) *(LAS unsigned short*)(IM + (l1p + 64 * k) * 2) = (unsigned short)f2bf(a[s].y); } }
        __syncthreads();
        { const int itn = FFT_ITEM((it0 + stride < NB * 4 * 8) ? it0 + stride : it0);
#pragma unroll
          for (int i = 0; i < 16; ++i) w[i] = __builtin_amdgcn_raw_buffer_load_b128(ry, (F.tid + 512 * i) * 16, itn * 131072, 0); }
        const int obase = ((b * SEQ) * D + 512 + g * 128 + 8 * cb) * 2;
#pragma unroll 2
        for (int i = 0; i < 8; ++i) { const int lp = F.tid + 512 * i, m = (SEQ - lp) & (SEQ - 1);
            const LAS unsigned char* rp_ = L + fft_row(lp & 63, lp >> 6) * 32;
            const f32x4 lo = *(const LAS f32x4*)rp_, hi = *(const LAS f32x4*)(rp_ + 16);
            float d0 = lo.x, m0 = lo.x;
            if (cb == 0) { const float rem = *(const LAS float*)(L + fft_row(m & 63, m >> 6) * 32);
                const float iml = bf2f(*(const LAS unsigned short*)(IM + lp * 2)), imm = bf2f(*(const LAS unsigned short*)(IM + m * 2));
                d0 = 0.5f * (lo.x + rem); m0 = 0.5f * (iml + imm); }
            v4u o; o.y = pk2(lo.z, lo.w); o.z = pk2(hi.x, hi.y); o.w = pk2(hi.z, hi.w);
            o.x = pk2(d0, lo.y); __builtin_amdgcn_raw_buffer_store_b128(o, rm, lp * D * 2, obase, 0);
            o.x = pk2(m0, lo.y); __builtin_amdgcn_raw_buffer_store_b128(o, rm, m * D * 2 + 128, obase, 0); }
    }
#undef FFT_ITEM
}
__device__ __forceinline__ void ph_mid(Frame& F) {
    float* vG = (float*)F.lds; float* vA = vG + D; float* vB = vA + D;
    const bf16* mo = (const bf16*)(F.ws + WS_MIXOUT); bf16* hf = (bf16*)(F.ws + WS_H);
    typedef float f32x2 __attribute__((ext_vector_type(2)));
    const f32x2* tm = (const f32x2*)(F.ws + WS_TM);
    f32x2 pre[3];
#pragma unroll
    for (int k = 0; k < 3; ++k) pre[k] = tm[k * (D / 2) + F.tid];
    for (int b = 0; b < NB; ++b) {
        __syncthreads();
#pragma unroll
        for (int k = 0; k < 3; ++k) ((f32x2*)vG)[k * (D / 2) + F.tid] = pre[k];
        __syncthreads();
        if (b + 1 < NB) {
#pragma unroll
            for (int k = 0; k < 3; ++k) pre[k] = tm[(size_t)(b + 1) * 3 * (D / 2) + k * (D / 2) + F.tid]; }
        for (int rb = blockIdx.x; rb < SEQ / 16; rb += F.G) {
            const size_t row0 = (size_t)b * SEQ + (size_t)rb * 16 + 2 * F.wave;
            f32x4 v[2][4], xv[2][4]; float ss[2];
#pragma unroll
            for (int q = 0; q < 2; ++q) { const size_t row = row0 + q;
                const v2u* mr4 = (const v2u*)(mo + row * D) + F.lane; const f32x4* xr = (const f32x4*)(F.x + row * D) + F.lane;
#pragma unroll
                for (int j = 0; j < 4; ++j) { const v2u w = mr4[64 * j]; v[q][j] = (f32x4){bflo(w.x), bfhi(w.x), bflo(w.y), bfhi(w.y)}; xv[q][j] = xr[64 * j]; } }
#pragma unroll
            for (int q = 0; q < 2; ++q) { ss[q] = 0.f;
#pragma unroll
                for (int j = 0; j < 4; ++j) ss[q] += (v[q][j].x * v[q][j].x + v[q][j].y * v[q][j].y) + (v[q][j].z * v[q][j].z + v[q][j].w * v[q][j].w); }
#pragma unroll
            for (int q = 0; q < 2; ++q) { const float rstd = rsqrtf(wave_sum(ss[q]) * (1.f / D) + NORM_EPS); float s1 = 0.f;
#pragma unroll
                for (int j = 0; j < 4; ++j) { const int c0 = 4 * F.lane + 256 * j; const f32x4 g = *(const f32x4*)(vG + c0);
                    v[q][j] = xv[q][j] + v[q][j] * rstd * g; s1 += (v[q][j].x * v[q][j].x + v[q][j].y * v[q][j].y) + (v[q][j].z * v[q][j].z + v[q][j].w * v[q][j].w); }
                ss[q] = s1; }
#pragma unroll
            for (int q = 0; q < 2; ++q) { const float rstd1 = rsqrtf(wave_sum(ss[q]) * (1.f / D) + NORM_EPS); const size_t row = row0 + q;
                unsigned long long* o8 = (unsigned long long*)(hf + row * D) + F.lane; unsigned long long* x8 = (unsigned long long*)((bf16*)(F.ws + WS_X1B) + row * D) + F.lane;
#pragma unroll
                for (int j = 0; j < 4; ++j) { const int c0 = 4 * F.lane + 256 * j; const f32x4 a = *(const f32x4*)(vA + c0), bb = *(const f32x4*)(vB + c0);
                    const f32x4 h = v[q][j] * rstd1 * a + bb;
                    x8[64 * j] = (unsigned long long)pk2(v[q][j].x, v[q][j].y) | ((unsigned long long)pk2(v[q][j].z, v[q][j].w) << 32);
                    o8[64 * j] = (unsigned long long)pk2(h.x, h.y) | ((unsigned long long)pk2(h.z, h.w) << 32); } }
        }
    }
}
__device__ __forceinline__ void ph_gate_table(Frame& F) {
    if ((int)blockIdx.x < 64 && F.tid < 256) { const int b = (int)blockIdx.x >> 2, col = 256 * ((int)blockIdx.x & 3) + F.tid;
        ((float*)(F.ws + WS_TG2))[b * D + col] = F.g_ffn_post[col] * mod_val(F, b, 5, col);
        float* tm = (float*)(F.ws + WS_TM) + (size_t)b * 3 * D;
        tm[col] = F.g_mix_post[col] * mod_val(F, b, 2, col); tm[D + col] = F.g_ffn_pre[col] * (1.f + mod_val(F, b, 4, col)); tm[2 * D + col] = mod_val(F, b, 3, col); }
}
__device__ __forceinline__ void ph_final(Frame& F) {
    float* vG2 = (float*)F.lds; const bf16* ff = (const bf16*)(F.ws + WS_FFN); const bf16* x1b = (const bf16*)(F.ws + WS_X1B);
    __syncthreads();
    { const f32x4* tg = (const f32x4*)(F.ws + WS_TG2);
      for (int i = F.tid; i < NB * D / 4; i += NTHR) ((f32x4*)vG2)[i] = tg[i]; }
    __syncthreads();
    for (int b = 0; b < NB; ++b)
    for (int rb = blockIdx.x; rb < SEQ / 16; rb += F.G) {
        const size_t row0 = (size_t)b * SEQ + (size_t)rb * 16 + 2 * F.wave;
        f32x4 v[2][4], xv[2][4]; float ss[2];
#pragma unroll
        for (int q = 0; q < 2; ++q) { const size_t row = row0 + q;
            const v2u* fr4 = (const v2u*)(ff + row * D) + F.lane; const v2u* xr = (const v2u*)(x1b + row * D) + F.lane;
#pragma unroll
            for (int j = 0; j < 4; ++j) { const v2u w = fr4[64 * j]; v[q][j] = (f32x4){bflo(w.x), bfhi(w.x), bflo(w.y), bfhi(w.y)};
                const v2u w2 = xr[64 * j]; xv[q][j] = (f32x4){bflo(w2.x), bfhi(w2.x), bflo(w2.y), bfhi(w2.y)}; } }
#pragma unroll
        for (int q = 0; q < 2; ++q) { ss[q] = 0.f;
#pragma unroll
            for (int j = 0; j < 4; ++j) ss[q] += (v[q][j].x * v[q][j].x + v[q][j].y * v[q][j].y) + (v[q][j].z * v[q][j].z + v[q][j].w * v[q][j].w); }
#pragma unroll
        for (int q = 0; q < 2; ++q) { const float rstd = rsqrtf(wave_sum(ss[q]) * (1.f / D) + NORM_EPS);
            f32x4* orow = (f32x4*)(F.out + (row0 + q) * D) + F.lane;
#pragma unroll
            for (int j = 0; j < 4; ++j) { const int c0 = 4 * F.lane + 256 * j; const f32x4 g2 = *(const f32x4*)(vG2 + b * D + c0);
                orow[64 * j] = xv[q][j] + v[q][j] * rstd * g2; } }
    }
}
#define XB_TMO      128
#define XB_XCNT(j)  (256  + 64 * (j))
#define XB_XSUB(j)  (1280 + 64 * (j))
#define XB_XGEN(j)  (2304 + 64 * (j))
#define XB_TOP      3328
#define XB_TOPGEN   3392
#define XCD_BAR_WORDS 3456
#define XB_SPIN_CAP (1u << 18)

__device__ __forceinline__ unsigned xb_ld(unsigned* p)              { return __hip_atomic_load(p, __ATOMIC_RELAXED, __HIP_MEMORY_SCOPE_AGENT); }
__device__ __forceinline__ unsigned xb_add(unsigned* p, unsigned v) { return __hip_atomic_fetch_add(p, v, __ATOMIC_RELAXED, __HIP_MEMORY_SCOPE_AGENT); }
__device__ __forceinline__ unsigned xb_xcc_id() { return (unsigned)__builtin_amdgcn_s_getreg((3 << 11) | 20) & 0xFu; }
#define XB_SPIN(cond, bar) do { unsigned _sp = 0; while (cond) { __builtin_amdgcn_s_sleep(1); \
    if ((++_sp & 255u) == 0u) { if (xb_ld(&(bar)[XB_TMO])) break; if (_sp > XB_SPIN_CAP) { atomicAdd(&(bar)[XB_TMO], 1u); break; } } } } while (0)

struct XcdBarrier {
    unsigned* bar; unsigned x;
    volatile LAS unsigned* st;
};

__device__ __forceinline__ XcdBarrier xcd_barrier_post(unsigned* bar, volatile LAS unsigned* st) {
    XcdBarrier b; b.bar = bar; b.x = xb_xcc_id(); b.st = st;
    if (threadIdx.x == 0) (void)xb_add(&bar[XB_XCNT(b.x)], 1u);
    return b;
}
__device__ __forceinline__ void xcd_barrier_complete(unsigned* bar, unsigned x, unsigned& nloc, unsigned& nx) {
    const unsigned G = gridDim.x * gridDim.y * gridDim.z;
    unsigned sum, cnt, mine, sp = 0u;
    for (;;) {
        sum = 0u; cnt = 0u; mine = 0u;
#pragma unroll
        for (unsigned j = 0; j < 16; ++j) { const unsigned c = xb_ld(&bar[XB_XCNT(j)]); sum += c; cnt += (c > 0u) ? 1u : 0u; mine = (j == x) ? c : mine; }
        if (sum == G) break;
        __builtin_amdgcn_s_sleep(1);
        if ((++sp & 255u) == 0u) { if (xb_ld(&bar[XB_TMO])) break; if (sp > XB_SPIN_CAP) { atomicAdd(&bar[XB_TMO], 1u); break; } }
    }
    nloc = mine > 0u ? mine : 1u; nx = cnt > 0u ? cnt : 1u;
}

__device__ __forceinline__ void xcd_barrier(const XcdBarrier& b) {
    asm volatile("s_waitcnt vmcnt(0)" ::: "memory");
    __syncthreads();
    if (threadIdx.x == 0) {
        unsigned* bar = b.bar;
        __builtin_amdgcn_s_waitcnt(0);
        unsigned nloc = b.st[0], nx = b.st[1];
        if (nloc == 0u) { xcd_barrier_complete(bar, b.x, nloc, nx); b.st[0] = nloc; b.st[1] = nx; }
        const unsigned old = xb_add(&bar[XB_XSUB(b.x)], 1u);
        const unsigned gen = old / nloc;
        if (old + 1u == (gen + 1u) * nloc) {
            __builtin_amdgcn_fence(__ATOMIC_RELEASE, "agent");
            asm volatile("s_waitcnt vmcnt(0)" ::: "memory");
            const unsigned og = xb_add(&bar[XB_TOP], 1u);
            const unsigned tg = og / nx;
            if (og + 1u == (tg + 1u) * nx) xb_add(&bar[XB_TOPGEN], 1u);
            else XB_SPIN(xb_ld(&bar[XB_TOPGEN]) == tg, bar);
            __builtin_amdgcn_fence(__ATOMIC_ACQUIRE, "agent");
            asm volatile("s_waitcnt vmcnt(0)" ::: "memory");
        } else {
            XB_SPIN(xb_ld(&bar[XB_TOPGEN]) == gen, bar);
            __builtin_amdgcn_fence(__ATOMIC_ACQUIRE, "agent");
            asm volatile("s_waitcnt vmcnt(0)" ::: "memory");
        }
    }
    __syncthreads();
}

constexpr int CW_BAR = 4096;
constexpr int LDS_BARST = LDS_BYTES - 256;
enum { PH_PREP = 0, PH_NORM1, PH_G1, PH_RSTATE, PH_ROUT, PH_G2, PH_MID, PH_G3, PH_G4, PH_FINAL, PH_COUNT };

__global__ void __launch_bounds__(NTHR, 2) mega(Args args) {
    extern __shared__ __attribute__((aligned(16))) unsigned char lds[];
    Frame F;
    F.lds = lds; F.tid = threadIdx.x; F.lane = F.tid & 63; F.wave = __builtin_amdgcn_readfirstlane(F.tid >> 6);
    F.G = gridDim.x; { const int bx = blockIdx.x; F.vcu = (F.G % 8 == 0) ? (bx % 8) * (F.G / 8) + bx / 8 : bx; }
    F.x = args.in[0]; F.c = args.in[1]; F.ctx = args.in[2]; F.c_ctx = args.in[3]; F.w_ada = args.in[4]; F.b_ada = args.in[5];
    F.g_mix_pre = args.in[6]; F.g_mix_post = args.in[7]; F.g_ffn_pre = args.in[8]; F.g_ffn_post = args.in[9]; F.w_in = args.in[10];
    F.dec_f = args.in[11]; F.dec_b = args.in[12]; F.w_out = args.in[13]; F.w_up = args.in[14]; F.conv_w = args.in[15]; F.conv_b = args.in[16]; F.w_down = args.in[17];
    F.out = args.out; F.ws = args.ws;
    PG8_LAS unsigned char* ldsl = (PG8_LAS unsigned char*)lds;
    const int lo = args.ph_lo, hi = args.ph_hi;
#define IN(k) (lo <= (k) && (k) < hi)
#define REFRESH() do { int t_ = threadIdx.x; asm volatile("" : "+v"(t_)); F.tid = t_; F.lane = t_ & 63; } while (0)
    volatile LAS unsigned* barst = (volatile LAS unsigned*)((LAS unsigned char*)ldsl + LDS_BARST);
    if (threadIdx.x < 2) barst[threadIdx.x] = 0u;
    __syncthreads();
    const XcdBarrier xbar = xcd_barrier_post((unsigned*)(args.ws + WS_CTL) + CW_BAR, barst);
    if (lo < 0) cg::this_grid().sync();
#define SEAM(k) do { if (IN(k) && IN((k) + 1)) xcd_barrier(xbar); } while (0)
    if (IN(PH_PREP)) { REFRESH(); ph_prep_ada(F); }
    SEAM(PH_PREP);
    if (IN(PH_NORM1)) { REFRESH(); ph_gate_table(F); if (blockIdx.x & 1) { REFRESH(); ph_prep_w(F); REFRESH(); ph_norm1(F); } else { REFRESH(); ph_norm1(F); REFRESH(); ph_prep_w(F); } }
    SEAM(PH_NORM1);
    if (IN(PH_G1)) {
        { pg8::Gemm g{(const bf16*)(F.ws + WS_H), (const bf16*)(F.ws + WS_WIN), M, INW, D}; pg8::StaticOrder S; S.init(M, INW, F.G, (int)blockIdx.x, WGM_G1);
          pg8::EpiInProj E{(bf16*)(F.ws + WS_PROJ), 0}; pg8::gemm_phase<pg8::EpiInProj, pg8::StaticOrder, true, true>(ldsl, g, S, E); }
        { pg8::Gemm g{(const bf16*)(F.ws + WS_HCTX), (const bf16*)(F.ws + WS_WIN) + (size_t)RETW * D, MCTX, 2 * RETW, D}; pg8::StaticOrder S; S.init(MCTX, 2 * RETW, F.G, (int)blockIdx.x, WGM_G1);
          pg8::EpiInProj E{(bf16*)(F.ws + WS_CKV), 1}; pg8::gemm_phase<pg8::EpiInProj, pg8::StaticOrder, true, true>(ldsl, g, S, E); }
        if (F.G > 64) { if ((int)blockIdx.x >= 64) { REFRESH(); ph_prep_wrest(F, ((int)blockIdx.x - 64) * NWAVES + F.wave, (F.G - 64) * NWAVES); } }
        else { REFRESH(); ph_prep_wrest(F, (int)blockIdx.x * NWAVES + F.wave, F.G * NWAVES); }
    }
    SEAM(PH_G1);
    if (IN(PH_RSTATE)) { const int half_id = (int)(((blockIdx.x >> 4) << 3) | (blockIdx.x & 7));
        if (F.G != 256) { REFRESH(); for (int ch = blockIdx.x; ch < 128; ch += F.G) ph_ret_states(F, (LAS unsigned char*)ldsl, ch); REFRESH(); ph_fft2(F, (LAS unsigned char*)ldsl, (int)blockIdx.x, F.G); }
        else if (((blockIdx.x >> 3) & 1) == 0) { REFRESH(); ph_ret_states_rs(F, (LAS unsigned char*)ldsl, half_id); }
        else { REFRESH(); ph_fft2(F, (LAS unsigned char*)ldsl, half_id, 128); } }
    SEAM(PH_RSTATE);
    if (IN(PH_ROUT)) { REFRESH(); ph_ret_out(F, (LAS unsigned char*)ldsl); }
    SEAM(PH_ROUT);
    if (IN(PH_G2)) { pg8::Gemm g{(const bf16*)(F.ws + WS_H), (const bf16*)(F.ws + WS_WOUT), M, D, D}; pg8::StaticOrder S; S.init(M, D, F.G, (int)blockIdx.x, WGM_G2);
        pg8::EpiBf16 E{(bf16*)(F.ws + WS_MIXOUT), D}; pg8::gemm_phase<pg8::EpiBf16, pg8::StaticOrder, true, true>(ldsl, g, S, E); }
    SEAM(PH_G2);
    if (IN(PH_MID)) { REFRESH(); ph_mid(F); }
    SEAM(PH_MID);
    if (IN(PH_G3)) { pg8::Gemm g{(const bf16*)(F.ws + WS_H), (const bf16*)(F.ws + WS_WUP), M, NUP, D}; pg8::StaticOrder S; S.init(M, NUP, F.G, (int)blockIdx.x, WGM_G3);
        pg8::EpiUp E{(bf16*)(F.ws + WS_ACT), F.conv_w, F.conv_b}; pg8::gemm_phase<pg8::EpiUp, pg8::StaticOrder, true, true>(ldsl, g, S, E); }
    SEAM(PH_G3);
    if (IN(PH_G4)) { pg8::Gemm g{(const bf16*)(F.ws + WS_ACT), (const bf16*)(F.ws + WS_WDN), M, D, DFF}; pg8::StaticOrder S; S.init(M, D, F.G, (int)blockIdx.x, WGM_G4);
        pg8::EpiBf16 E{(bf16*)(F.ws + WS_FFN), D}; pg8::gemm_phase<pg8::EpiBf16, pg8::StaticOrder, true, true>(ldsl, g, S, E); }
    SEAM(PH_G4);
    if (IN(PH_FINAL)) { REFRESH(); ph_final(F); }
#undef IN
}

extern "C" void kernel_launch(void* const* d_in, const int* in_sizes, int n_in, void* d_out, int out_size, void* d_ws, size_t ws_size, hipStream_t stream) {
    static int grid = 0;
    if (grid == 0) {
        if (n_in != 18 || out_size != M * D || ws_size < WS_END) { fprintf(stderr, "kernel_launch: unexpected shapes n_in %d out %d ws %zu\n", n_in, out_size, ws_size); grid = -1; return; }
        int dev = 0, cus = 0;
        if (hipGetDevice(&dev) != hipSuccess || hipDeviceGetAttribute(&cus, hipDeviceAttributeMultiprocessorCount, dev) != hipSuccess) { grid = -1; return; }
        if (hipFuncSetAttribute((const void*)mega, hipFuncAttributeMaxDynamicSharedMemorySize, LDS_BYTES) != hipSuccess) { fprintf(stderr, "hipFuncSetAttribute failed\n"); grid = -1; return; }
        int per_cu = 0;
        if (hipOccupancyMaxActiveBlocksPerMultiprocessor(&per_cu, (const void*)mega, NTHR, LDS_BYTES) != hipSuccess || per_cu < 1) { fprintf(stderr, "occupancy query: %d\n", per_cu); grid = -1; return; }
        grid = cus * per_cu;
    }
    if (grid < 0) return;
    if (hipMemsetAsync((char*)d_ws + WS_CTL, 0, 65536, stream) != hipSuccess) { fprintf(stderr, "memset failed\n"); return; }
    Args a{};
    for (int i = 0; i < 18; ++i) a.in[i] = (const float*)d_in[i];
    a.out = (float*)d_out; a.ws = (unsigned char*)d_ws;
#if MK_ONE_LAUNCH
    a.ph_lo = 0; a.ph_hi = PH_COUNT;
    void* kargs[] = {&a};
    hipError_t e = hipLaunchCooperativeKernel((const void*)mega, dim3(grid), dim3(NTHR), kargs, LDS_BYTES, stream);
    if (e != hipSuccess) fprintf(stderr, "cooperative launch failed: %s (grid %d)\n", hipGetErrorString(e), grid);
#else
    for (int ph = 0; ph < PH_COUNT; ++ph) { a.ph_lo = ph; a.ph_hi = ph + 1; hipLaunchKernelGGL(mega, dim3(grid), dim3(NTHR), LDS_BYTES, stream, a); }
#endif
}
```

```cpp
#include <hip/hip_runtime.h>
#include <cstdio>
#include <cstdint>
namespace pg8 {
#define PG8_LAS __attribute__((address_space(3)))
typedef unsigned short bf16_t;
typedef short bf16x8 __attribute__((ext_vector_type(8)));
typedef float f32x4 __attribute__((ext_vector_type(4)));
typedef unsigned u32x4 __attribute__((ext_vector_type(4)));
constexpr int BM = 256, BK = 64, HALF = 128, HTB = HALF * BK * 2  , STAGE_BYTES = 8 * HTB, NXCD = 8, WGM = 8;

__host__ __device__ __forceinline__ int lds_byte(int r, int c) { const int st = (r >> 4) * 2 + (c >> 5), rr = r & 15, cc = c & 31, ob = rr * 64 + cc * 2; return st * 1024 + (ob ^ (((ob >> 9) & 1) << 5)); }
__host__ __device__ __forceinline__ void stage_rc(int b, int& R, int& C) { const int st = b / 1024, sb = b % 1024, swz = sb ^ (((sb >> 9) & 1) << 5); R = (st >> 1) * 16 + swz / 64; C = (st & 1) * 32 + (swz % 64) / 2; }
__host__ __device__ __forceinline__ int perm32(int rho) { const int n = rho >> 4, i = rho & 15; return 8 * (i >> 2) + 4 * n + (i & 3); }

struct Unit { int pm, pn; };
struct Gemm { const bf16_t* A; const bf16_t* Bt; int M, N, K; };

struct StaticOrder {
    int nM, nN, nwg, G, c, wgm;
    __host__ __device__ void init(int M, int N, int G_, int c_, int wgm_ = 4) { nM = M / BM; nN = N / BM; nwg = nM * nN; G = G_; c = c_; wgm = wgm_; }
    __host__ __device__ bool next(int i, Unit& u) const {
        const long L = (long)i * G + c; if (L >= nwg) return false;
        int wgid = (int)L; { const int q = nwg / NXCD, r = nwg % NXCD, xcd = wgid % NXCD, off = wgid / NXCD; wgid = (xcd < r ? xcd * (q + 1) : r * (q + 1) + (xcd - r) * q) + off; }
        const int nig = wgm * nN, gid = wgid / nig, fm = gid * wgm, gsz = (nM - fm) < wgm ? (nM - fm) : wgm;
        u.pm = fm + ((wgid % nig) % gsz); u.pn = (wgid % nig) / gsz; return true;
    }
    __device__ __forceinline__ void a_ready(const Unit&) const {}
    __device__ __forceinline__ void done(const Unit&) const {}
};

__device__ __forceinline__ unsigned cvt_pk_bf16(float lo, float hi) { unsigned r; asm volatile("v_cvt_pk_bf16_f32 %0, %1, %2" : "=v"(r) : "v"(lo), "v"(hi)); return r; }
struct EpiF32 {
    static constexpr bool PERM = false, AFTER_DRAIN = false, PERMA = false, HAS_PREFETCH = false;
    float* C; int ldc;
    __device__ __forceinline__ void operator()(const f32x4 (&acc)[2][2][4][2], const Unit& u, int wr, int wc, int fr, int fq) const {
        const int row0 = u.pm * BM + wr * 64 + fr, col0 = u.pn * BM + wc * 32 + 4 * fq;
#pragma unroll
        for (int ai = 0; ai < 2; ++ai)
#pragma unroll
            for (int m = 0; m < 4; ++m) { float* rowp = C + (size_t)(row0 + ai * HALF + m * 16) * ldc + col0;
#pragma unroll
                for (int bj = 0; bj < 2; ++bj)
#pragma unroll
                    for (int n = 0; n < 2; ++n) *(f32x4*)(rowp + bj * HALF + n * 16) = acc[ai][bj][m][n]; }
    }
};
struct EpiBf16 {
    static constexpr bool PERM = true, AFTER_DRAIN = false, PERMA = false, HAS_PREFETCH = false;
    bf16_t* O; int ldc;
    __device__ __forceinline__ void operator()(const f32x4 (&acc)[2][2][4][2], const Unit& u, int wr, int wc, int fr, int fq) const {
        const int row0 = u.pm * BM + wr * 64 + fr; const int col0 = u.pn * BM + wc * 32 + 8 * fq;
#pragma unroll
        for (int ai = 0; ai < 2; ++ai)
#pragma unroll
            for (int m = 0; m < 4; ++m) { bf16_t* rowp = O + (size_t)(row0 + ai * HALF + m * 16) * ldc + col0;
#pragma unroll
                for (int bj = 0; bj < 2; ++bj) { const f32x4 v0 = acc[ai][bj][m][0], v1 = acc[ai][bj][m][1];
                    u32x4 w; w.x = cvt_pk_bf16(v0[0], v0[1]); w.y = cvt_pk_bf16(v0[2], v0[3]); w.z = cvt_pk_bf16(v1[0], v1[1]); w.w = cvt_pk_bf16(v1[2], v1[3]);
                    *(u32x4*)(rowp + bj * HALF) = w; } }
    }
};

struct EpiInProj {
    static constexpr bool PERM = true, AFTER_DRAIN = false, PERMA = false, HAS_PREFETCH = false;
    bf16_t* O; int mode;
    __device__ __forceinline__ void store8(bf16_t* p, f32x4 v0, f32x4 v1) const {
        u32x4 w; w.x = cvt_pk_bf16(v0[0], v0[1]); w.y = cvt_pk_bf16(v0[2], v0[3]); w.z = cvt_pk_bf16(v1[0], v1[1]); w.w = cvt_pk_bf16(v1[2], v1[3]); *(u32x4*)p = w; }
    __device__ __forceinline__ void operator()(const f32x4 (&acc)[2][2][4][2], const Unit& u, int wr, int wc, int fr, int fq) const {
        const float KS = 0.08838834764831845f;
        constexpr size_t NHc = 4, SEQc = 4096, DHc = 128, LCc = 256, QKVG_T = (size_t)16 * NHc * SEQc * DHc;
        size_t base, bjstep; int pitch;
        if (mode == 0) {
            if (u.pn < 8) { base = (size_t)(u.pn >> 1) * QKVG_T + (((size_t)(u.pm >> 4) * NHc + 2 * (u.pn & 1)) * SEQc + (size_t)(u.pm & 15) * BM) * DHc; bjstep = SEQc * DHc; pitch = (int)DHc; }
            else { base = 4 * QKVG_T + (((((size_t)(u.pm >> 4) * 4 + 2 * (u.pn - 8)) * 8 + 2 * wc + (fq >> 1)) * SEQc + (size_t)(u.pm & 15) * BM) * 16 + 8 * (fq & 1)) - (size_t)(wc * 32 + 8 * fq);
                   bjstep = (size_t)8 * SEQc * 16; pitch = 16; }
        } else { base = (size_t)(u.pn >> 1) * (16 * NHc * LCc * DHc) + (((size_t)u.pm * NHc + 2 * (u.pn & 1)) * LCc) * DHc; bjstep = LCc * DHc; pitch = (int)DHc; }
        bf16_t* Ob = O + base + wc * 32 + 8 * fq;
        const int rl0 = wr * 64 + fr;
        if (mode == 0 && u.pn < 4) {
            int fqo = fq; asm volatile("" : "+v"(fqo));
            f32x4 rv;
#pragma unroll
            for (int j = 0; j < 4; ++j) rv[j] = exp2f(-(float)(16 * (wc & 1) + 4 * fqo + j) * (13.287712379549449f / 32.f)) * 0.15915494309189535f;
            const float ks = (u.pn >= 2) ? KS : 1.f;
            if (wc < 2) {
#pragma unroll
                for (int ai = 0; ai < 2; ++ai) { const float pos = (float)((4 * u.pm + 2 * ai + wr) & 63); f32x4 cs, sn;
#pragma unroll
                    for (int j = 0; j < 4; ++j) { const float a = pos * rv[j]; cs[j] = __builtin_amdgcn_cosf(a) * ks; sn[j] = __builtin_amdgcn_sinf(a) * ks; }
#pragma unroll
                    for (int m = 0; m < 4; ++m) { bf16_t* rowp = Ob + (size_t)(rl0 + ai * HALF + m * 16) * pitch;
#pragma unroll
                        for (int bj = 0; bj < 2; ++bj) { const f32x4 t1 = acc[ai][bj][m][0], t2 = acc[ai][bj][m][1]; store8(rowp + bj * bjstep, t1 * cs - t2 * sn, t1 * sn + t2 * cs); } }
                    asm volatile("" ::: "memory"); }
            } else {
#pragma unroll
                for (int m = 0; m < 4; ++m) { const float pos = (float)(16 * m + fr); f32x4 cs, sn;
#pragma unroll
                    for (int j = 0; j < 4; ++j) { const float a = pos * rv[j]; cs[j] = __builtin_amdgcn_cosf(a) * ks; sn[j] = __builtin_amdgcn_sinf(a) * ks; }
#pragma unroll
                    for (int ai = 0; ai < 2; ++ai) { bf16_t* rowp = Ob + (size_t)(rl0 + ai * HALF + m * 16) * pitch;
#pragma unroll
                        for (int bj = 0; bj < 2; ++bj) { const f32x4 t1 = acc[ai][bj][m][0], t2 = acc[ai][bj][m][1]; store8(rowp + bj * bjstep, t1 * cs - t2 * sn, t1 * sn + t2 * cs); } }
                    asm volatile("" ::: "memory"); }
            }
        } else {
            const float sc = (mode == 1 && u.pn < 2) ? KS : 1.f;
#pragma unroll
            for (int ai = 0; ai < 2; ++ai)
#pragma unroll
                for (int m = 0; m < 4; ++m) { bf16_t* rowp = Ob + (size_t)(rl0 + ai * HALF + m * 16) * pitch;
#pragma unroll
                    for (int bj = 0; bj < 2; ++bj) store8(rowp + bj * bjstep, acc[ai][bj][m][0] * sc, acc[ai][bj][m][1] * sc); }
        }
    }
};
__device__ __forceinline__ f32x4 dpp_shr1(f32x4 v) { f32x4 r;
#pragma unroll
    for (int j = 0; j < 4; ++j) { const float x = v[j]; r[j] = __int_as_float(__builtin_amdgcn_update_dpp(0, __float_as_int(x), 0x111, 0xf, 0xf, true)); }
    return r; }
__device__ __forceinline__ f32x4 dpp_shl1(f32x4 v) { f32x4 r;
#pragma unroll
    for (int j = 0; j < 4; ++j) { const float x = v[j]; r[j] = __int_as_float(__builtin_amdgcn_update_dpp(0, __float_as_int(x), 0x101, 0xf, 0xf, true)); }
    return r; }
struct EpiUp {
    static constexpr bool PERM = true, AFTER_DRAIN = false, PERMA = true, HAS_PREFETCH = true;
    bf16_t* O; const float* ct;
    typedef float f32x2 __attribute__((ext_vector_type(2)));
    typedef unsigned u32x2 __attribute__((ext_vector_type(2)));
    static constexpr int CONV_LDS = STAGE_BYTES;
    __device__ __forceinline__ void prefetch(PG8_LAS unsigned char* lds, const Unit& u, int wid, int lane, int ui) const {
        if (wid < 4) { const int q = wid * 64 + lane, vec = q >> 5, part = q & 31; constexpr int NUPc = 5632, DFFc = 2816;
            const float* src = ct + (vec & 3) * NUPc + (vec >> 2) * DFFc + u.pn * HALF + part * 4;
            __builtin_amdgcn_global_load_lds((const unsigned*)src, (PG8_LAS unsigned*)(lds + CONV_LDS + (ui & 1) * 4096 + wid * 1024), 16, 0, 0); }
    }
    static __device__ __forceinline__ f32x2 fma2(f32x2 a, f32x2 b, f32x2 c) { return __builtin_elementwise_fma(a, b, c); }
    __device__ __forceinline__ void run(const f32x4 (&acc)[2][2][4][2], const Unit& u, int wr, int wc, int fr, int fq, PG8_LAS unsigned char* lds, int ui) const {
        constexpr int DFFc = 2816;
        u32x2 keep[2][4];
#pragma unroll
        for (int n = 0; n < 2; ++n) {
            const PG8_LAS f32x4* cv = (const PG8_LAS f32x4*)(lds + CONV_LDS + (ui & 1) * 4096 + (wc * 32 + 8 * fq + 4 * n) * 4);
            const f32x4 wa0 = cv[0], wa1 = cv[32], wa2 = cv[64], ba = cv[96];
            const f32x4 wb0 = cv[128], wb1 = cv[160], wb2 = cv[192], bb = cv[224];
#pragma unroll
            for (int ai = 0; ai < 2; ++ai) {
                bf16_t* rowp = O + (size_t)(u.pm * BM + ai * HALF + wr * 64 + 4 * fr) * DFFc + (u.pn * HALF + wc * 32 + 8 * fq);
                const f32x4 pa = dpp_shr1(acc[ai][0][3][n]), pb = dpp_shr1(acc[ai][1][3][n]), na = dpp_shl1(acc[ai][0][0][n]), nb = dpp_shl1(acc[ai][1][0][n]);
#pragma unroll
                for (int m = 0; m < 4; ++m) {
                    const f32x4 ap = (m == 0) ? pa : acc[ai][0][m == 0 ? 0 : m - 1][n], bp = (m == 0) ? pb : acc[ai][1][m == 0 ? 0 : m - 1][n];
                    const f32x4 an = (m == 3) ? na : acc[ai][0][m == 3 ? 3 : m + 1][n], bn = (m == 3) ? nb : acc[ai][1][m == 3 ? 3 : m + 1][n];
                    const f32x4 ac = acc[ai][0][m][n], bc = acc[ai][1][m][n];
                    f32x2 alo = fma2(wa1.lo, ac.lo, ba.lo), ahi = fma2(wa1.hi, ac.hi, ba.hi), blo = fma2(wb1.lo, bc.lo, bb.lo), bhi = fma2(wb1.hi, bc.hi, bb.hi);
                    alo = fma2(wa0.lo, ap.lo, alo); ahi = fma2(wa0.hi, ap.hi, ahi); blo = fma2(wb0.lo, bp.lo, blo); bhi = fma2(wb0.hi, bp.hi, bhi);
                    alo = fma2(wa2.lo, an.lo, alo); ahi = fma2(wa2.hi, an.hi, ahi); blo = fma2(wb2.lo, bn.lo, blo); bhi = fma2(wb2.hi, bn.hi, bhi);
                    f32x2 elo, ehi; elo.x = __builtin_amdgcn_exp2f(alo.x); elo.y = __builtin_amdgcn_exp2f(alo.y); ehi.x = __builtin_amdgcn_exp2f(ahi.x); ehi.y = __builtin_amdgcn_exp2f(ahi.y);
                    elo = elo + 1.f; ehi = ehi + 1.f;
                    f32x2 rlo, rhi; rlo.x = __builtin_amdgcn_rcpf(elo.x); rlo.y = __builtin_amdgcn_rcpf(elo.y); rhi.x = __builtin_amdgcn_rcpf(ehi.x); rhi.y = __builtin_amdgcn_rcpf(ehi.y);
                    const f32x2 olo = (alo * blo) * rlo, ohi = (ahi * bhi) * rhi;
                    u32x2 w; w.x = cvt_pk_bf16(olo.x, olo.y); w.y = cvt_pk_bf16(ohi.x, ohi.y);
                    if (n == 0) keep[ai][m] = w;
                    else { u32x4 w4; w4.x = keep[ai][m].x; w4.y = keep[ai][m].y; w4.z = w.x; w4.w = w.y; *(u32x4*)(rowp + (size_t)m * DFFc) = w4; }
                }
                asm volatile("" ::: "memory");
            }
        }
    }
};
template <class Epi, class Sched, bool ALIGN_EPI = false, bool SP2 = false>
__device__ __forceinline__ void gemm_phase(PG8_LAS unsigned char* lds, const Gemm g, const Sched& S, const Epi& E) {
    int tid_o = threadIdx.x; asm volatile("" : "+v"(tid_o));
    const int tid = tid_o, wid = __builtin_amdgcn_readfirstlane(tid >> 6), lane = tid & 63, wr = wid >> 2, wc = wid & 3, fr = lane & 15, fq = lane >> 4;
    const int K = g.K, nt = K / BK;
    unsigned voffA[2], voffB[2];
#pragma unroll
    for (int i = 0; i < 2; ++i) { int R, C; stage_rc(tid * 16 + i * 8192, R, C); const int Rb = Epi::PERM ? ((R & ~31) + perm32(R & 31)) : R;
        const int Ra = Epi::PERMA ? ((R & ~63) | ((R & 15) << 2) | ((R >> 4) & 3)) : R;
        voffA[i] = (unsigned)(Ra * K + C) * 2u; voffB[i] = (unsigned)(Rb * K + C) * 2u; }
    const size_t kstep = (size_t)(BK * 2);
    const size_t hstep = (size_t)HALF * K * 2;
    const size_t tstep = 2 * hstep;
    const unsigned ldsw = (unsigned)wid * 1024u;
    const int aoff = lds_byte(wr * 64 + fr, fq * 8), boff = lds_byte(wc * 32 + fr, fq * 8);
#define PG8_SA(b, h) (((b) * 2 + (h)) * HTB)
#define PG8_SB(b, h) ((4 + (b) * 2 + (h)) * HTB)
#define PG8_STAGE(bufoff, gbase, voff) do { _Pragma("unroll") for (int _i = 0; _i < 2; ++_i) \
        __builtin_amdgcn_global_load_lds((const unsigned*)((const char*)(gbase) + (voff)[_i]), (PG8_LAS unsigned*)(lds + (bufoff) + ldsw + _i * 8192), 16, 0, 0); } while (0)
#define PG8_LDA(dst, b, h) do { _Pragma("unroll") for (int m = 0; m < 4; ++m) _Pragma("unroll") for (int k = 0; k < 2; ++k) dst[m][k] = *(const PG8_LAS bf16x8*)(lds + PG8_SA(b, h) + aoff + m * 2048 + k * 1024); } while (0)
#define PG8_LDB(dst, b, h) do { _Pragma("unroll") for (int n = 0; n < 2; ++n) _Pragma("unroll") for (int k = 0; k < 2; ++k) dst[n][k] = *(const PG8_LAS bf16x8*)(lds + PG8_SB(b, h) + boff + n * 2048 + k * 1024); } while (0)
#define PG8_MMA(ai, bj, At, Bt) do { __builtin_amdgcn_s_setprio(1); _Pragma("unroll") for (int m = 0; m < 4; ++m) _Pragma("unroll") for (int n = 0; n < 2; ++n) _Pragma("unroll") for (int k = 0; k < 2; ++k) \
        acc[ai][bj][m][n] = __builtin_amdgcn_mfma_f32_16x16x32_bf16(Bt[n][k], At[m][k], acc[ai][bj][m][n], 0, 0, 0); __builtin_amdgcn_s_setprio(0); } while (0)
#define PG8_WAIT_V(n) asm volatile("s_waitcnt vmcnt(" #n ")" ::: "memory")
#define PG8_WAIT_L(n) asm volatile("s_waitcnt lgkmcnt(" #n ")" ::: "memory")
#define PG8_BAR __builtin_amdgcn_s_barrier()
#define PG8_SCHED __builtin_amdgcn_sched_barrier(0)
    Unit cur, nxt; int ui = 0;
    if (!S.next(0, cur)) return;
    f32x4 acc[2][2][4][2];
#pragma unroll
    for (int a = 0; a < 2; ++a)
#pragma unroll
        for (int b = 0; b < 2; ++b)
#pragma unroll
            for (int m = 0; m < 4; ++m)
#pragma unroll
                for (int n = 0; n < 2; ++n) acc[a][b][m][n] = (f32x4){0.f, 0.f, 0.f, 0.f};
    bf16x8 At[4][2], B0[2][2], B1[2][2];
    const char* cA = (const char*)g.A + (size_t)cur.pm * tstep; const char* cB = (const char*)g.Bt + (size_t)cur.pn * tstep;
    S.a_ready(cur);
    if constexpr (Epi::HAS_PREFETCH) E.prefetch(lds, cur, wid, lane, ui);
    if constexpr (SP2) {
        PG8_STAGE(PG8_SB(0, 0), cB, voffB); PG8_STAGE(PG8_SB(0, 1), cB + hstep, voffB); PG8_STAGE(PG8_SA(0, 0), cA, voffA); PG8_STAGE(PG8_SA(0, 1), cA + hstep, voffA);
        if (wr == 1) PG8_BAR;
        PG8_WAIT_V(2); PG8_BAR;
        PG8_STAGE(PG8_SB(1, 0), cB + kstep, voffB); PG8_STAGE(PG8_SA(1, 0), cA + kstep, voffA); PG8_STAGE(PG8_SB(1, 1), cB + hstep + kstep, voffB);
        PG8_WAIT_V(6); PG8_BAR;
    } else {
        PG8_STAGE(PG8_SB(0, 0), cB, voffB); PG8_STAGE(PG8_SA(0, 0), cA, voffA); PG8_STAGE(PG8_SB(0, 1), cB + hstep, voffB); PG8_STAGE(PG8_SA(0, 1), cA + hstep, voffA);
        if (wr == 1) PG8_BAR;
        PG8_WAIT_V(4); PG8_BAR;
        PG8_STAGE(PG8_SB(1, 0), cB + kstep, voffB); PG8_STAGE(PG8_SA(1, 0), cA + kstep, voffA); PG8_STAGE(PG8_SB(1, 1), cB + hstep + kstep, voffB);
        PG8_WAIT_V(6); PG8_BAR;
    }
    for (;;) {
        const bool has_next = S.next(ui + 1, nxt);
        const char* nA = has_next ? (const char*)g.A + (size_t)nxt.pm * tstep : cA; const char* nB = has_next ? (const char*)g.Bt + (size_t)nxt.pn * tstep : cB;
        for (int t = 0; t < nt; t += 2) {
            const bool last = (t == nt - 2);
            const char* a1 = cA + (size_t)(t + 1) * kstep;
            const char* a2 = last ? nA : cA + (size_t)(t + 2) * kstep; const char* b2 = last ? nB : cB + (size_t)(t + 2) * kstep;
            const char* a3 = a2 + kstep; const char* b3 = b2 + kstep;
            if (last && has_next) S.a_ready(nxt);
            if constexpr (SP2) {
            PG8_LDB(B0, 0, 0); PG8_LDB(B1, 0, 1); PG8_SCHED; PG8_LDA(At, 0, 0); PG8_STAGE(PG8_SA(1, 1), a1 + hstep, voffA);
            PG8_WAIT_V(8); PG8_WAIT_L(0); PG8_BAR; PG8_MMA(0, 0, At, B0); PG8_MMA(0, 1, At, B1); PG8_BAR; PG8_SCHED;
            PG8_LDA(At, 0, 1); PG8_STAGE(PG8_SB(0, 0), b2, voffB); PG8_STAGE(PG8_SB(0, 1), b2 + hstep, voffB); PG8_STAGE(PG8_SA(0, 0), a2, voffA);
            PG8_WAIT_V(8); PG8_WAIT_L(0); PG8_BAR; PG8_MMA(1, 0, At, B0); PG8_MMA(1, 1, At, B1); PG8_BAR; PG8_SCHED;
            PG8_LDB(B0, 1, 0); PG8_LDB(B1, 1, 1); PG8_SCHED; PG8_LDA(At, 1, 0); PG8_STAGE(PG8_SA(0, 1), a2 + hstep, voffA);
            PG8_WAIT_V(8); PG8_WAIT_L(0); PG8_BAR; PG8_MMA(0, 0, At, B0); PG8_MMA(0, 1, At, B1); PG8_BAR; PG8_SCHED;
            PG8_LDA(At, 1, 1); PG8_STAGE(PG8_SB(1, 0), b3, voffB); PG8_STAGE(PG8_SB(1, 1), b3 + hstep, voffB); PG8_STAGE(PG8_SA(1, 0), a3, voffA);
            PG8_WAIT_V(8); PG8_WAIT_L(0); PG8_BAR; PG8_MMA(1, 0, At, B0); PG8_MMA(1, 1, At, B1); PG8_BAR; PG8_SCHED;
            } else {
            PG8_LDB(B0, 0, 0); PG8_SCHED; PG8_LDA(At, 0, 0); PG8_STAGE(PG8_SA(1, 1), a1 + hstep, voffA);
            PG8_WAIT_L(8); PG8_BAR; PG8_WAIT_L(0); PG8_MMA(0, 0, At, B0); PG8_BAR; PG8_SCHED;
            PG8_LDB(B1, 0, 1); PG8_STAGE(PG8_SB(0, 0), b2, voffB);
            PG8_BAR; PG8_WAIT_L(0); PG8_MMA(0, 1, At, B1); PG8_BAR;
            PG8_LDA(At, 0, 1); PG8_STAGE(PG8_SA(0, 0), a2, voffA);
            PG8_BAR; PG8_WAIT_L(0); PG8_MMA(1, 0, At, B0); PG8_BAR; PG8_SCHED;
            PG8_STAGE(PG8_SB(0, 1), b2 + hstep, voffB);
            PG8_WAIT_V(6); PG8_BAR; PG8_MMA(1, 1, At, B1); PG8_BAR;
            PG8_LDB(B0, 1, 0); PG8_SCHED; PG8_LDA(At, 1, 0); PG8_STAGE(PG8_SA(0, 1), a2 + hstep, voffA);
            PG8_WAIT_L(8); PG8_BAR; PG8_WAIT_L(0); PG8_MMA(0, 0, At, B0); PG8_BAR; PG8_SCHED;
            PG8_LDB(B1, 1, 1); PG8_STAGE(PG8_SB(1, 0), b3, voffB);
            PG8_BAR; PG8_WAIT_L(0); PG8_MMA(0, 1, At, B1); PG8_BAR;
            PG8_LDA(At, 1, 1); PG8_STAGE(PG8_SA(1, 0), a3, voffA);
            PG8_BAR; PG8_WAIT_L(0); PG8_MMA(1, 0, At, B0); PG8_BAR; PG8_SCHED;
            PG8_STAGE(PG8_SB(1, 1), b3 + hstep, voffB);
            PG8_WAIT_V(6); PG8_BAR; PG8_MMA(1, 1, At, B1); PG8_BAR;
            }
        }
        if constexpr (ALIGN_EPI) { if (wr == 0) PG8_BAR; }
        if constexpr (Epi::HAS_PREFETCH) { E.run(acc, cur, wr, wc, fr, fq, lds, ui); S.done(cur); }
        else if constexpr (!Epi::AFTER_DRAIN) { E(acc, cur, wr, wc, fr, fq); S.done(cur); }
        if (!has_next) break;
#pragma unroll
        for (int a = 0; a < 2; ++a)
#pragma unroll
            for (int b = 0; b < 2; ++b)
#pragma unroll
                for (int m = 0; m < 4; ++m)
#pragma unroll
                    for (int n = 0; n < 2; ++n) acc[a][b][m][n] = (f32x4){0.f, 0.f, 0.f, 0.f};
        cur = nxt; cA = nA; cB = nB; ++ui;
        if constexpr (Epi::HAS_PREFETCH) E.prefetch(lds, cur, wid, lane, ui);
        if constexpr (ALIGN_EPI) { if (wr == 1) PG8_BAR; }
    }
    PG8_WAIT_V(0);
    if constexpr (!ALIGN_EPI) { if (wr == 0) PG8_BAR; }
    PG8_BAR;
    if constexpr (Epi::AFTER_DRAIN) { E.fused(acc, cur, wr, wc, fr, fq, lds, wid, lane); S.done(cur); }
#undef PG8_SA
#undef PG8_SB
#undef PG8_STAGE
#undef PG8_LDA
#undef PG8_LDB
#undef PG8_MMA
#undef PG8_WAIT_V
#undef PG8_WAIT_L
#undef PG8_BAR
#undef PG8_SCHED
}
}

#include <hip/hip_cooperative_groups.h>
namespace cg = cooperative_groups;
#ifndef MK_ONE_LAUNCH
#define MK_ONE_LAUNCH 1
#endif
#ifndef WGM_G1
#define WGM_G1 4
#endif
#ifndef WGM_G2
#define WGM_G2 4
#endif
#ifndef WGM_G3
#define WGM_G3 4
#endif
#ifndef WGM_G4
#define WGM_G4 4
#endif
constexpr int NWAVES = 8, NTHR = 512;
constexpr int NB = 16, SEQ = 4096, D = 1024, M = NB * SEQ, LCTX = 256, MCTX = NB * LCTX, NH = 4, DH = 128, RETW = 512, INW = 2560, DFF = 2816, NUP = 5632, NMOD = 6144;
constexpr float NORM_EPS = 1e-6f;
constexpr size_t MiB = 1u << 20;
constexpr size_t WS_CTL = 0, CTL_ZERO_BYTES = 1 * MiB;
constexpr size_t WS_TG2 = 256 * 1024;
constexpr size_t WS_TM = 384 * 1024;
constexpr size_t WS_CONVT = 600 * 1024;
constexpr size_t WS_MODP = 1 * MiB;
constexpr size_t WS_WIN = 5 * MiB, WS_WOUT = 10 * MiB, WS_WUP = 12 * MiB, WS_WDN = 23 * MiB;
constexpr size_t WS_SCTX = 29 * MiB;
constexpr size_t WS_HCTX = 38 * MiB, WS_CKV = 46 * MiB;
constexpr size_t WS_H = 64 * MiB;
constexpr size_t WS_PROJ = 192 * MiB;
constexpr size_t WS_MIXOUT = 192 * MiB;
constexpr size_t WS_ACT = 544 * MiB;
constexpr size_t WS_FFN = 320 * MiB;
constexpr size_t WS_X1B = 896 * MiB;
constexpr size_t QKVG_T = (size_t)NB * NH * SEQ * DH;
constexpr size_t PROJ_Y = 4 * QKVG_T;
constexpr size_t CKV_T = (size_t)NB * NH * LCTX * DH;
constexpr size_t WS_END = 1024 * MiB;
constexpr int LDS_BYTES = 147456;

#define LAS __attribute__((address_space(3)))
typedef unsigned short bf16;
typedef unsigned v4u __attribute__((ext_vector_type(4)));
typedef unsigned v2u __attribute__((ext_vector_type(2)));
typedef float f32x4 __attribute__((ext_vector_type(4)));
__device__ __forceinline__ unsigned f2bf(float f) { unsigned u = __builtin_bit_cast(unsigned, f); return (u + 0x7fffu + ((u >> 16) & 1u)) >> 16; }
__device__ __forceinline__ unsigned pk2(float lo, float hi) { unsigned r; asm("v_cvt_pk_bf16_f32 %0, %1, %2" : "=v"(r) : "v"(lo), "v"(hi)); return r; }
__device__ __forceinline__ float bf2f(unsigned short b) { return __builtin_bit_cast(float, ((unsigned)b) << 16); }
__device__ __forceinline__ float bflo(unsigned w) { return __builtin_bit_cast(float, w << 16); }
__device__ __forceinline__ float bfhi(unsigned w) { return __builtin_bit_cast(float, w & 0xffff0000u); }
__device__ __forceinline__ float silu_f(float x) { return x * __builtin_amdgcn_rcpf(1.f + __builtin_amdgcn_exp2f(-1.4426950408889634f * x)); }
template <int CTRL, int ROWMASK> __device__ __forceinline__ float dpp_add(float v) { return v + __int_as_float(__builtin_amdgcn_update_dpp(0, __float_as_int(v), CTRL, ROWMASK, 0xf, true)); }
__device__ __forceinline__ float wave_sum(float v) {
    v = dpp_add<0xB1, 0xf>(v);
    v = dpp_add<0x4E, 0xf>(v);
    v = dpp_add<0x141, 0xf>(v);
    v = dpp_add<0x140, 0xf>(v);
    v = dpp_add<0x142, 0xa>(v);
    v = dpp_add<0x143, 0xc>(v);
    return __int_as_float(__builtin_amdgcn_readlane(__float_as_int(v), 63));
}

struct Args { const float* in[18]; float* out; unsigned char* ws; int ph_lo, ph_hi; };
struct Frame {
    unsigned char* lds; int tid, lane, wave, vcu, G;
    const float *x, *c, *ctx, *c_ctx, *w_ada, *b_ada, *g_mix_pre, *g_mix_post, *g_ffn_pre, *g_ffn_post, *w_in, *dec_f, *dec_b, *w_out, *w_up, *conv_w, *conv_b, *w_down;
    float* out; unsigned char* ws;
};

template <int MODE>
__device__ __forceinline__ void p0_transpose_item(const float* W, int K, int N, int nblk, bf16* WT, float* scr, int item, int lane) {
    const int kb = item / nblk, nb = item % nblk, k0 = 64 * kb, n0 = 32 * nb;
    int sc = n0 + (lane & 31);
    if (MODE == 1 && sc < 1024) { const int lc = sc & 127; sc = (sc & ~127) + 64 * ((lc >> 2) & 1) + 16 * (lc >> 5) + 4 * ((lc >> 3) & 3) + (lc & 3); }
    if (MODE == 2) { const int tcn = sc & 255; sc = (tcn >> 7) * 2816 + 128 * (sc >> 8) + (tcn & 127); }
    float wl[32];
#pragma unroll
    for (int i = 0; i < 32; ++i) { const int kk = 2 * i + (lane >> 5); int kr = k0 + kk;
        if (MODE == 3 && kr >= 512 && (kr & 127) > 64) kr = (kr & ~127) + 192 - (kr & 127);
        wl[i] = W[(size_t)kr * N + sc]; }
#pragma unroll
    for (int i = 0; i < 32; ++i) { const int kk = 2 * i + (lane >> 5); scr[kk * 33 + (lane & 31)] = wl[i]; }
    asm volatile("s_waitcnt lgkmcnt(0)" ::: "memory");
    const int c = lane & 7;
#pragma unroll
    for (int j = 0; j < 4; ++j) { const int n = (lane >> 3) + 8 * j; const float* s = scr + (8 * c) * 33 + n;
        v4u o; o.x = pk2(s[0 * 33], s[1 * 33]); o.y = pk2(s[2 * 33], s[3 * 33]); o.z = pk2(s[4 * 33], s[5 * 33]); o.w = pk2(s[6 * 33], s[7 * 33]);
        *(v4u*)(WT + (size_t)(n0 + n) * K + k0 + 8 * c) = o; }
    asm volatile("s_waitcnt lgkmcnt(0)" ::: "memory");
}

__device__ __forceinline__ void ph_prep_w(Frame& F) {
    __syncthreads();
    float* scr = (float*)(F.lds + F.wave * 16384);
    const int gw = F.vcu * NWAVES + F.wave, NGW = F.G * NWAVES;
    constexpr int I_IN = (D / 64) * (2048 / 32), I_OUT = (D / 64) * (D / 32), I_UP = (D / 64) * (NUP / 32), I_DN = (DFF / 64) * (D / 32);
    for (int it = gw; it < I_IN; it += NGW) p0_transpose_item<1>(F.w_in, D, INW, 64, (bf16*)(F.ws + WS_WIN), scr, it, F.lane);
    __syncthreads();
    {
        float* Wl = (float*)F.lds; float* tc = Wl + 16 * 128; float* ts = tc + 128;
        if (F.tid < 128) { tc[F.tid] = __builtin_amdgcn_cosf((float)F.tid * (1.f / 128.f)); ts[F.tid] = __builtin_amdgcn_sinf((float)F.tid * (1.f / 128.f)); }
        bf16* WT = (bf16*)(F.ws + WS_WIN);
        const float fsc = 0.0013810679320049757f;
        for (int it = blockIdx.x; it < 64 * 4; it += F.G) {
            const int kb = it >> 2, g = it & 3;
            __syncthreads();
            { float wq[4];
#pragma unroll
              for (int q = 0; q < 4; ++q) { const int i = F.tid + NTHR * q; wq[q] = F.w_in[(size_t)(kb * 16 + (i >> 7)) * INW + 2048 + g * 128 + (i & 127)]; }
#pragma unroll
              for (int q = 0; q < 4; ++q) Wl[F.tid + NTHR * q] = wq[q]; }
            __syncthreads();
            const int o = F.tid & 127, kq = F.tid >> 7, p = o >> 1, part = o & 1;
            float a0 = 0.f, a1 = 0.f, a2 = 0.f, a3 = 0.f;
            for (int c = 0; c < 128; ++c) {
                const int ix = (c * p) & 127;
                float cf = part ? -ts[ix] : tc[ix];
                if (p == 0 && part) cf = tc[(64 * c) & 127];
                a0 += Wl[(4 * kq + 0) * 128 + c] * cf; a1 += Wl[(4 * kq + 1) * 128 + c] * cf; a2 += Wl[(4 * kq + 2) * 128 + c] * cf; a3 += Wl[(4 * kq + 3) * 128 + c] * cf;
            }
            v2u w; w.x = pk2(a0 * fsc, a1 * fsc); w.y = pk2(a2 * fsc, a3 * fsc);
            *(v2u*)(WT + (size_t)(2048 + g * 128 + o) * D + kb * 16 + 4 * kq) = w;
        }
    }
    __syncthreads();
}
__device__ __forceinline__ void ph_prep_wrest(Frame& F, int gw, int NGW) {
    __syncthreads();
    float* scr = (float*)(F.lds + F.wave * 16384);
    constexpr int I_OUT = (D / 64) * (D / 32), I_UP = (D / 64) * (NUP / 32), I_DN = (DFF / 64) * (D / 32);
    for (int it = gw; it < I_OUT + I_UP + I_DN; it += NGW) {
        int r = it;
        if (r < I_OUT) { p0_transpose_item<3>(F.w_out, D, D, D / 32, (bf16*)(F.ws + WS_WOUT), scr, r, F.lane); continue; } r -= I_OUT;
        if (r < I_UP) { p0_transpose_item<2>(F.w_up, D, NUP, NUP / 32, (bf16*)(F.ws + WS_WUP), scr, r, F.lane); continue; } r -= I_UP;
        p0_transpose_item<0>(F.w_down, DFF, D, D / 32, (bf16*)(F.ws + WS_WDN), scr, r, F.lane);
    }
    __syncthreads();
}
__device__ __forceinline__ void ph_prep_ada(Frame& F) {
    __syncthreads();
    float* sil = (float*)F.lds;
    float* red = (float*)(F.lds + 16384);
    float* modp = (float*)(F.ws + WS_MODP);
    for (int it = blockIdx.x; it < 24 * 8; it += F.G) {
        const int jc = it % 24, kc = it / 24;
        const int col = jc * 256 + (F.tid & 255), kh = F.tid >> 8;
        float wv[64];
#pragma unroll
        for (int j = 0; j < 64; ++j) wv[j] = F.w_ada[(size_t)(kc * 128 + kh * 64 + j) * NMOD + col];
        { float cv[5];
#pragma unroll
          for (int q = 0; q < 5; ++q) { const int i = F.tid + NTHR * q, r = i >> 7, kk = i & 127; cv[q] = (i < 17 * 128) ? ((r < 16) ? F.c[r * D + kc * 128 + kk] : F.c_ctx[kc * 128 + kk]) : 0.f; }
#pragma unroll
          for (int q = 0; q < 5; ++q) { const int i = F.tid + NTHR * q; if (i < 17 * 128) sil[i] = silu_f(cv[q]); } }
        __syncthreads();
        float acc[17];
#pragma unroll
        for (int r = 0; r < 17; ++r) acc[r] = 0.f;
#pragma unroll
        for (int j = 0; j < 64; ++j) { const float w = wv[j];
#pragma unroll
            for (int r = 0; r < 17; ++r) acc[r] += sil[r * 128 + kh * 64 + j] * w; }
        if (kh == 1) {
#pragma unroll
            for (int r = 0; r < 17; ++r) red[r * 256 + (F.tid & 255)] = acc[r]; }
        __syncthreads();
        if (kh == 0) {
#pragma unroll
            for (int r = 0; r < 17; ++r) modp[(size_t)(kc * 17 + r) * NMOD + col] = acc[r] + red[r * 256 + (F.tid & 255)]; }
        __syncthreads();
    }
}
__device__ __forceinline__ float mod_val(const Frame& F, int mr, int ch, int col) {
    const float* modp = (const float*)(F.ws + WS_MODP); const int j = ch * D + col; float s = F.b_ada[j];
#pragma unroll
    for (int kc = 0; kc < 8; ++kc) s += modp[(size_t)(kc * 17 + mr) * NMOD + j];
    return s;
}
__device__ __forceinline__ void ph_norm1(Frame& F) {
    float* vA = (float*)F.lds; float* vB = vA + D; float* vAc = vB + D; float* vBc = vAc + D;
    for (int grp = blockIdx.x; grp < M / 256; grp += F.G) {
        const int mr = grp / 16;
        __syncthreads();
        bool staged = false;
        for (int r = 2 * F.wave; r < 256 + 16; r += 2 * NWAVES) {
            const bool is_ctx = r >= 256;
            const float* src = is_ctx ? F.ctx + ((size_t)grp * 16 + (r - 256)) * D : F.x + ((size_t)grp * 256 + r) * D;
            bf16* dst = is_ctx ? (bf16*)(F.ws + WS_HCTX) + ((size_t)grp * 16 + (r - 256)) * D : (bf16*)(F.ws + WS_H) + ((size_t)grp * 256 + r) * D;
            const float* pa = is_ctx ? vAc : vA; const float* pb = is_ctx ? vBc : vB;
            f32x4 v[2][4]; float ss[2];
#pragma unroll
            for (int q = 0; q < 2; ++q) { const f32x4* xr = (const f32x4*)(src + (size_t)q * D) + F.lane;
#pragma unroll
                for (int j = 0; j < 4; ++j) v[q][j] = xr[64 * j]; }
            if (!staged) { staged = true;
                for (int col = F.tid; col < D; col += NTHR) { const float gp = F.g_mix_pre[col];
                    vA[col] = gp * (1.f + mod_val(F, mr, 1, col)); vB[col] = mod_val(F, mr, 0, col);
                    vAc[col] = gp * (1.f + mod_val(F, 16, 1, col)); vBc[col] = mod_val(F, 16, 0, col); }
                __syncthreads(); }
#pragma unroll
            for (int q = 0; q < 2; ++q) { ss[q] = 0.f;
#pragma unroll
                for (int j = 0; j < 4; ++j) ss[q] += (v[q][j].x * v[q][j].x + v[q][j].y * v[q][j].y) + (v[q][j].z * v[q][j].z + v[q][j].w * v[q][j].w); }
#pragma unroll
            for (int q = 0; q < 2; ++q) { const float rstd = rsqrtf(wave_sum(ss[q]) * (1.f / D) + NORM_EPS);
                unsigned long long* o8 = (unsigned long long*)(dst + (size_t)q * D) + F.lane;
#pragma unroll
                for (int j = 0; j < 4; ++j) { const int c0 = 4 * F.lane + 256 * j; const f32x4 a = *(const f32x4*)(pa + c0), b = *(const f32x4*)(pb + c0);
                    const f32x4 h = v[q][j] * rstd * a + b;
                    o8[64 * j] = (unsigned long long)pk2(h.x, h.y) | ((unsigned long long)pk2(h.z, h.w) << 32); } }
        }
    }
}
__device__ __forceinline__ float log_gamma(const float* dec, int h) { const float xv = dec[h]; return -log1pf(expf(-xv)); }
constexpr size_t WS_ST = 512 * MiB;
typedef short s16x4 __attribute__((ext_vector_type(4)));
typedef short bf16x8 __attribute__((ext_vector_type(8)));
#define RET_KP 272
#define RET_VP 144
__device__ __forceinline__ bf16x8 tr2(LAS unsigned char* a0, LAS unsigned char* a1) {
    const s16x4 lo = __builtin_amdgcn_ds_read_tr16_b64_v4i16((LAS s16x4*)a0), hi = __builtin_amdgcn_ds_read_tr16_b64_v4i16((LAS s16x4*)a1);
    return __builtin_shufflevector(lo, hi, 0, 1, 2, 3, 4, 5, 6, 7);
}
__device__ __forceinline__ v4u scale8(v4u w, float z) {
    v4u o;
#pragma unroll
    for (int j = 0; j < 4; ++j) o[j] = pk2(bflo(w[j]) * z, bfhi(w[j]) * z);
    return o;
}
__device__ __forceinline__ int r1_sw(int row) { return ((row & 3) << 1) | (((row >> 3) & 1) << 3); }
__device__ __forceinline__ void ph_ret_states(Frame& F, LAS unsigned char* L, int ch) {
    const bf16* proj = (const bf16*)(F.ws + WS_PROJ); const bf16* ckv = (const bf16*)(F.ws + WS_CKV); bf16* ST = (bf16*)(F.ws + WS_ST);
    const int w = F.wave, l = F.lane, fq = l >> 4, g = l >> 4, q = (l & 15) >> 2, p = l & 3, wd = w >> 2, we = w & 3;
    constexpr int TILEB = 128 * 256, BUFB = 2 * TILEB;
    {
        const int dir = ch & 1, h = (ch >> 1) & 3, b = ch >> 3;
        const float l2 = log_gamma(dir ? F.dec_b : F.dec_f, h) * 1.4426950408889634f;
        const float cd = exp2f(128.f * l2);
        float zv[4]; int woff[4];
#pragma unroll
        for (int i = 0; i < 4; ++i) { const int qi = F.tid + 512 * i, c = qi >> 4; zv[i] = exp2f((float)(dir ? c : 127 - c) * l2); woff[i] = c * 256 + (((qi & 15) ^ r1_sw(c)) << 4); }
        const int trow = 8 * g + q, tsw = r1_sw(trow);
        int aoff[4], boff[2];
#pragma unroll
        for (int mf = 0; mf < 4; ++mf) aoff[mf] = trow * 256 + ((((8 * wd + 2 * mf) + (p >> 1)) ^ tsw) << 4) + (p & 1) * 8;
#pragma unroll
        for (int nf = 0; nf < 2; ++nf) boff[nf] = trow * 256 + ((((4 * we + 2 * nf) + (p >> 1)) ^ tsw) << 4) + (p & 1) * 8;
        pg8::f32x4 acc[4][2];
#pragma unroll
        for (int mf = 0; mf < 4; ++mf)
#pragma unroll
            for (int nf = 0; nf < 2; ++nf) acc[mf][nf] = (pg8::f32x4){0.f, 0.f, 0.f, 0.f};
        v4u kA[4], vA[4], kB[4], vB[4];
        __syncthreads();
#define R1_SRC(s, kp, vp) do { if ((s) < 2) { const int cchunk = dir ? 1 - (s) : (s); kp = ckv + ((size_t)(b * NH + h) * LCTX + cchunk * 128) * DH; vp = kp + CKV_T; } \
            else { const int n_ = dir ? 31 - ((s) - 2) : (s) - 2; kp = proj + QKVG_T + ((size_t)(b * NH + h) * SEQ + n_ * 128) * DH; vp = kp + QKVG_T; } } while (0)
#define R1_ISSUE(s, kr, vr) do { const bf16* kp_; const bf16* vp_; R1_SRC(s, kp_, vp_); \
            _Pragma("unroll") for (int i = 0; i < 4; ++i) { const int qi = F.tid + 512 * i; kr[i] = *(const v4u*)(kp_ + qi * 8); vr[i] = *(const v4u*)(vp_ + qi * 8); } } while (0)
#define R1_WRITE(s, buf, kr, vr) do { LAS unsigned char* kb_ = L + (buf) * BUFB; LAS unsigned char* vb_ = kb_ + TILEB; \
            _Pragma("unroll") for (int i = 0; i < 4; ++i) { *(LAS v4u*)(kb_ + woff[i]) = kr[i]; *(LAS v4u*)(vb_ + woff[i]) = scale8(vr[i], zv[i]); } } while (0)
#define R1_STEP(s, buf, ST_) do { \
            if (ST_) { const int n = dir ? 31 - ((s) - 2) : (s) - 2; \
                bf16* sp = ST + ((size_t)(((b * NH + h) * 2 + dir) * 32 + n) << 14) + (size_t)(32 * we + (l & 15)) * DH + 64 * wd + 4 * fq; \
                _Pragma("unroll") for (int mf = 0; mf < 4; ++mf) _Pragma("unroll") for (int nf = 0; nf < 2; ++nf) { v2u o; o.x = pk2(acc[mf][nf][0], acc[mf][nf][1]); o.y = pk2(acc[mf][nf][2], acc[mf][nf][3]); *(v2u*)(sp + nf * 16 * DH + mf * 16) = o; } } \
            _Pragma("unroll") for (int mf = 0; mf < 4; ++mf) _Pragma("unroll") for (int nf = 0; nf < 2; ++nf) acc[mf][nf] = acc[mf][nf] * cd; \
            LAS unsigned char* kb = L + (buf) * BUFB; LAS unsigned char* vb = kb + TILEB; \
            _Pragma("unroll") for (int ks = 0; ks < 4; ++ks) { bf16x8 Bv[2]; \
                _Pragma("unroll") for (int nf = 0; nf < 2; ++nf) { LAS unsigned char* va = vb + boff[nf] + ks * 32 * 256; Bv[nf] = tr2(va, va + 4 * 256); } \
                _Pragma("unroll") for (int mf = 0; mf < 4; ++mf) { LAS unsigned char* ka = kb + aoff[mf] + ks * 32 * 256; const bf16x8 A = tr2(ka, ka + 4 * 256); \
                    _Pragma("unroll") for (int nf = 0; nf < 2; ++nf) acc[mf][nf] = __builtin_amdgcn_mfma_f32_16x16x32_bf16(A, Bv[nf], acc[mf][nf], 0, 0, 0); } } } while (0)
        R1_ISSUE(0, kA, vA); R1_WRITE(0, 0, kA, vA);
        __syncthreads();
        R1_ISSUE(1, kA, vA); R1_ISSUE(2, kB, vB);
        R1_STEP(0, 0, false); R1_WRITE(1, 1, kA, vA); __syncthreads(); R1_ISSUE(3, kA, vA);
        R1_STEP(1, 1, false); R1_WRITE(2, 0, kB, vB); __syncthreads(); R1_ISSUE(4, kB, vB);
#pragma unroll 1
        for (int s = 2; s < 34; s += 2) {
            const int s3 = (s + 3 < 34) ? s + 3 : 33, s4 = (s + 4 < 34) ? s + 4 : 33;
            R1_STEP(s, 0, true);
            R1_WRITE(s + 1, 1, kA, vA);
            __syncthreads();
            R1_ISSUE(s3, kA, vA);
            R1_STEP(s + 1, 1, true);
            R1_WRITE(s + 2, 0, kB, vB);
            __syncthreads();
            R1_ISSUE(s4, kB, vB);
        }
#undef R1_SRC
#undef R1_ISSUE
#undef R1_WRITE
#undef R1_STEP
    }
}
__device__ __forceinline__ void ph_ret_states_rs(Frame& F, LAS unsigned char* L, int ch) {
    const bf16* proj = (const bf16*)(F.ws + WS_PROJ); const bf16* ckv = (const bf16*)(F.ws + WS_CKV); bf16* ST = (bf16*)(F.ws + WS_ST);
    const int w = F.wave, l = F.lane;
    constexpr int TILEB = 128 * 256, BUFB = 2 * TILEB;
    const int dir = ch & 1, h = (ch >> 1) & 3, b = ch >> 3;
    const float l2 = log_gamma(dir ? F.dec_b : F.dec_f, h) * 1.4426950408889634f;
    __syncthreads();
#define RS_SRC(s, kp, vp) do { if ((s) < 2) { const int cchunk = dir ? 1 - (s) : (s); kp = ckv + ((size_t)(b * NH + h) * LCTX + cchunk * 128) * DH; vp = kp + CKV_T; } \
        else { const int n_ = dir ? 31 - ((s) - 2) : (s) - 2; kp = proj + QKVG_T + ((size_t)(b * NH + h) * SEQ + n_ * 128) * DH; vp = kp + QKVG_T; } } while (0)
    if (w < 4) {
        const int lt = F.tid;
        float zv[8]; int woff[8];
#pragma unroll
        for (int i = 0; i < 8; ++i) { const int qi = lt + 256 * i, c = qi >> 4; zv[i] = exp2f((float)(dir ? c : 127 - c) * l2); woff[i] = c * 256 + (((qi & 15) ^ r1_sw(c)) << 4); }
        v4u kA[8], vA[8], kB[8], vB[8];
#define RS_ISSUE(s, kr, vr) do { const bf16* kp_; const bf16* vp_; RS_SRC(s, kp_, vp_); \
            _Pragma("unroll") for (int i = 0; i < 8; ++i) { const int qi = lt + 256 * i; kr[i] = *(const v4u*)(kp_ + qi * 8); vr[i] = *(const v4u*)(vp_ + qi * 8); } } while (0)
#define RS_WRITE(buf, kr, vr) do { LAS unsigned char* kb_ = L + (buf) * BUFB; LAS unsigned char* vb_ = kb_ + TILEB; \
            _Pragma("unroll") for (int i = 0; i < 8; ++i) { *(LAS v4u*)(kb_ + woff[i]) = kr[i]; *(LAS v4u*)(vb_ + woff[i]) = scale8(vr[i], zv[i]); } } while (0)
        RS_ISSUE(0, kA, vA); RS_WRITE(0, kA, vA);
        __syncthreads();
        RS_ISSUE(1, kA, vA); RS_ISSUE(2, kB, vB);
#pragma unroll 1
        for (int s = 0; s < 34; s += 2) {
            const int s3 = (s + 3 < 34) ? s + 3 : 33, s4 = (s + 4 < 34) ? s + 4 : 33;
            RS_WRITE(1, kA, vA); __syncthreads(); RS_ISSUE(s3, kA, vA);
            RS_WRITE(0, kB, vB); __syncthreads(); RS_ISSUE(s4, kB, vB);
        }
#undef RS_ISSUE
#undef RS_WRITE
    } else {
        const int cw = w - 4, wd = cw >> 1, we = cw & 1, fq = l >> 4, g = l >> 4, q = (l & 15) >> 2, p = l & 3;
        const float cd = exp2f(128.f * l2);
        const int trow = 8 * g + q, tsw = r1_sw(trow);
        int aoff[4], boff[4];
#pragma unroll
        for (int mf = 0; mf < 4; ++mf) { aoff[mf] = trow * 256 + ((((8 * wd + 2 * mf) + (p >> 1)) ^ tsw) << 4) + (p & 1) * 8; boff[mf] = trow * 256 + ((((8 * we + 2 * mf) + (p >> 1)) ^ tsw) << 4) + (p & 1) * 8; }
        pg8::f32x4 acc[4][4];
#pragma unroll
        for (int mf = 0; mf < 4; ++mf)
#pragma unroll
            for (int nf = 0; nf < 4; ++nf) acc[mf][nf] = (pg8::f32x4){0.f, 0.f, 0.f, 0.f};
#define RS_STEP(s, buf, ST_) do { \
            if (ST_) { const int n = dir ? 31 - ((s) - 2) : (s) - 2; \
                bf16* sp = ST + ((size_t)(((b * NH + h) * 2 + dir) * 32 + n) << 14) + (size_t)(64 * we + (l & 15)) * DH + 64 * wd + 4 * fq; \
                _Pragma("unroll") for (int mf = 0; mf < 4; ++mf) _Pragma("unroll") for (int nf = 0; nf < 4; ++nf) { v2u o; o.x = pk2(acc[mf][nf][0], acc[mf][nf][1]); o.y = pk2(acc[mf][nf][2], acc[mf][nf][3]); *(v2u*)(sp + nf * 16 * DH + mf * 16) = o; } } \
            _Pragma("unroll") for (int mf = 0; mf < 4; ++mf) _Pragma("unroll") for (int nf = 0; nf < 4; ++nf) acc[mf][nf] = acc[mf][nf] * cd; \
            LAS unsigned char* kb = L + (buf) * BUFB; LAS unsigned char* vb = kb + TILEB; \
            _Pragma("unroll") for (int ks = 0; ks < 4; ++ks) { bf16x8 Bv[4]; \
                _Pragma("unroll") for (int nf = 0; nf < 4; ++nf) { LAS unsigned char* va = vb + boff[nf] + ks * 32 * 256; Bv[nf] = tr2(va, va + 4 * 256); } \
                _Pragma("unroll") for (int mf = 0; mf < 4; ++mf) { LAS unsigned char* ka = kb + aoff[mf] + ks * 32 * 256; const bf16x8 A = tr2(ka, ka + 4 * 256); \
                    _Pragma("unroll") for (int nf = 0; nf < 4; ++nf) acc[mf][nf] = __builtin_amdgcn_mfma_f32_16x16x32_bf16(A, Bv[nf], acc[mf][nf], 0, 0, 0); } } } while (0)
        __syncthreads();
        RS_STEP(0, 0, false); __syncthreads();
        RS_STEP(1, 1, false); __syncthreads();
#pragma unroll 1
        for (int s = 2; s < 34; s += 2) {
            RS_STEP(s, 0, true); __syncthreads();
            RS_STEP(s + 1, 1, true); __syncthreads();
        }
#undef RS_STEP
    }
#undef RS_SRC
}
__device__ __forceinline__ void ph_ret_out(Frame& F, LAS unsigned char* L) {
    const __amdgpu_buffer_rsrc_t rp = __builtin_amdgcn_make_buffer_rsrc((void*)(F.ws + WS_PROJ), (short)0, (int)((size_t)M * INW * 2), 0x00020000);
    const __amdgpu_buffer_rsrc_t rs = __builtin_amdgcn_make_buffer_rsrc((void*)(F.ws + WS_ST), (short)0, (int)((size_t)NB * NH * 2 * 32 * 16384 * 2), 0x00020000);
    const __amdgpu_buffer_rsrc_t rm = __builtin_amdgcn_make_buffer_rsrc((void*)(F.ws + WS_H), (short)0, (int)((size_t)M * D * 2), 0x00020000);
    const int w = F.wave, l = F.lane, fq = l >> 4, g = l >> 4, q = (l & 15) >> 2, p = l & 3, li = l & 15;
    constexpr int TB = 128 * RET_KP;
    constexpr int VP = 288;
    constexpr int TS = 128 * 256;
    LAS unsigned char* Kt = L; LAS unsigned char* Tf = L + TS; LAS unsigned char* Tb = L + 2 * TS; LAS unsigned char* Vt = L + 3 * TS;
    const int iloc = 16 * w + li;
    v4u r0[4], r1[4];
    int vkv[4], vst[4];
#pragma unroll
    for (int i = 0; i < 4; ++i) { const int qi = F.tid + 512 * i; vkv[i] = qi * 16; vst[i] = qi * 16; }
    const int vq = (iloc * DH + 8 * fq) * 2, vg = (iloc * DH + 4 * fq) * 2, vo = (iloc * D + 4 * fq) * 2;
#define R2_ISSUE_KV(it) do { const int n_ = (it) & 31, h_ = ((it) >> 5) & 3, b_ = (it) >> 7; const int s0_ = (((b_ * NH + h_) * SEQ + n_ * 128) * DH) * 2; \
        _Pragma("unroll") for (int i = 0; i < 4; ++i) { r0[i] = __builtin_amdgcn_raw_buffer_load_b128(rp, vkv[i], s0_ + (int)(QKVG_T * 2), 0); r1[i] = __builtin_amdgcn_raw_buffer_load_b128(rp, vkv[i], s0_ + (int)(2 * QKVG_T * 2), 0); } } while (0)
#define R2_ISSUE_Q(it, dst) do { const int n_ = (it) & 31, h_ = ((it) >> 5) & 3, b_ = (it) >> 7; const int s0_ = (((b_ * NH + h_) * SEQ + n_ * 128) * DH) * 2; \
        _Pragma("unroll") for (int ks = 0; ks < 4; ++ks) dst[ks] = __builtin_amdgcn_raw_buffer_load_b128(rp, vq + ks * 64, s0_, 0); } while (0)
    v4u Qn[4];
    if ((int)blockIdx.x < NB * NH * 32) { R2_ISSUE_KV((int)blockIdx.x); R2_ISSUE_Q((int)blockIdx.x, Qn); }
    LAS float* DT = (LAS float*)(L + 3 * TS + 128 * VP);
    int hmk = -1;
    for (int item = blockIdx.x; item < NB * NH * 32; item += F.G) {
        const int n = item & 31, h = (item >> 5) & 3, b = item >> 7;
        const size_t tok0 = (size_t)b * SEQ + n * 128;
        const float l2f = log_gamma(F.dec_f, h) * 1.4426950408889634f, l2b = log_gamma(F.dec_b, h) * 1.4426950408889634f;
        if (h != hmk) { hmk = h; if (F.tid < 255) { const int dd = 127 - F.tid; DT[F.tid] = __builtin_amdgcn_exp2f(dd >= 0 ? (float)dd * l2f : (float)(-dd) * l2b); } }
        bf16x8 Qf[4];
#pragma unroll
        for (int ks = 0; ks < 4; ++ks) Qf[ks] = __builtin_bit_cast(bf16x8, Qn[ks]);
#pragma unroll
        for (int i = 0; i < 4; ++i) { const int qi = F.tid + 512 * i, off = (qi >> 4) * 256 + ((((qi & 15) ^ (qi >> 4)) & 15) << 4); *(LAS v4u*)(Kt + off) = r0[i]; *(LAS v4u*)(Vt + (qi >> 4) * VP + (qi & 15) * 16) = r1[i]; }
        __syncthreads();
        v4u r2[4], r3[4];
        { const int sf = ((((b * NH + h) * 2 + 0) * 32 + n) << 15), sb = ((((b * NH + h) * 2 + 1) * 32 + n) << 15);
#pragma unroll
          for (int i = 0; i < 4; ++i) { r2[i] = __builtin_amdgcn_raw_buffer_load_b128(rs, vst[i], sf, 0); r3[i] = __builtin_amdgcn_raw_buffer_load_b128(rs, vst[i], sb, 0); } }
        bf16x8 Pk[4];
        const LAS float* dtl = DT + (127 - iloc + 4 * fq);
#pragma unroll
        for (int hv = 0; hv < 2; ++hv) {
            pg8::f32x4 st[4];
#pragma unroll
            for (int m4 = 0; m4 < 4; ++m4) { const int mf = 4 * hv + m4; st[m4] = (pg8::f32x4){0.f, 0.f, 0.f, 0.f};
#pragma unroll
                for (int ks = 0; ks < 4; ++ks) { const bf16x8 A = *(const LAS bf16x8*)(Kt + (16 * mf + li) * 256 + (((4 * ks + fq) ^ li) << 4));
                    st[m4] = __builtin_amdgcn_mfma_f32_16x16x32_bf16(A, Qf[ks], st[m4], 0, 0, 0); } }
#pragma unroll
            for (int s2 = 0; s2 < 2; ++s2) { const int s = 2 * hv + s2; float v[8];
#pragma unroll
                for (int hh = 0; hh < 2; ++hh)
#pragma unroll
                    for (int r = 0; r < 4; ++r) v[4 * hh + r] = st[2 * s2 + hh][r] * dtl[32 * s + 16 * hh + r];
                v4u pkd; pkd.x = pk2(v[0], v[1]); pkd.y = pk2(v[2], v[3]); pkd.z = pk2(v[4], v[5]); pkd.w = pk2(v[6], v[7]);
                Pk[s] = __builtin_bit_cast(bf16x8, pkd); }
            asm volatile("" ::: "memory");
        }
        pg8::f32x4 ot[8];
#pragma unroll
        for (int mf = 0; mf < 8; ++mf) { pg8::f32x4 o = (pg8::f32x4){0.f, 0.f, 0.f, 0.f};
#pragma unroll
            for (int s = 0; s < 4; ++s) { LAS unsigned char* va = Vt + (32 * s + 4 * g + q) * VP + (16 * mf + 4 * p) * 2;
                const bf16x8 A = tr2(va, va + 16 * VP);
                o = __builtin_amdgcn_mfma_f32_16x16x32_bf16(A, Pk[s], o, 0, 0, 0); }
            ot[mf] = o; }
#pragma unroll
        for (int i = 0; i < 4; ++i) { const int qi = F.tid + 512 * i, off = (qi >> 4) * 256 + ((((qi & 15) ^ (qi >> 4)) & 15) << 4); *(LAS v4u*)(Tf + off) = r2[i]; *(LAS v4u*)(Tb + off) = r3[i]; }
        __syncthreads();
        if (item + F.G < NB * NH * 32) { R2_ISSUE_KV(item + F.G); R2_ISSUE_Q(item + F.G, Qn); }
        const float xf = __builtin_amdgcn_exp2f((float)(iloc + 1) * l2f), xb = __builtin_amdgcn_exp2f((float)(128 - iloc) * l2b);
        const int sg = (((b * NH + h) * SEQ + n * 128) * DH) * 2 + (int)(3 * QKVG_T * 2), so = (int)((tok0 * D + h * DH) * 2);
        v2u gw[8];
#pragma unroll
        for (int mf = 0; mf < 8; ++mf) gw[mf] = __builtin_amdgcn_raw_buffer_load_b64(rp, vg + 32 * mf, sg, 0);
        float ss = 0.f;
#pragma unroll
        for (int mf = 0; mf < 8; ++mf) {
            pg8::f32x4 c1 = (pg8::f32x4){0.f, 0.f, 0.f, 0.f}, c2 = c1;
#pragma unroll
            for (int ks = 0; ks < 4; ++ks) { const bf16x8 Af = *(const LAS bf16x8*)(Tf + (16 * mf + li) * 256 + (((4 * ks + fq) ^ li) << 4));
                const bf16x8 Ab = *(const LAS bf16x8*)(Tb + (16 * mf + li) * 256 + (((4 * ks + fq) ^ li) << 4));
                c1 = __builtin_amdgcn_mfma_f32_16x16x32_bf16(Af, Qf[ks], c1, 0, 0, 0);
                c2 = __builtin_amdgcn_mfma_f32_16x16x32_bf16(Ab, Qf[ks], c2, 0, 0, 0); }
            const pg8::f32x4 o = ot[mf] + c1 * xf + c2 * xb; ot[mf] = o; ss += (o[0] * o[0] + o[1] * o[1]) + (o[2] * o[2] + o[3] * o[3]);
        }
        ss += __shfl_xor(ss, 16); ss += __shfl_xor(ss, 32);
        const float rstd = rsqrtf(ss * (1.f / DH) + NORM_EPS);
#pragma unroll
        for (int mf = 0; mf < 8; ++mf) { const v2u gv = gw[mf];
            v2u o; o.x = pk2(ot[mf][0] * rstd * silu_f(bflo(gv.x)), ot[mf][1] * rstd * silu_f(bfhi(gv.x))); o.y = pk2(ot[mf][2] * rstd * silu_f(bflo(gv.y)), ot[mf][3] * rstd * silu_f(bfhi(gv.y)));
            __builtin_amdgcn_raw_buffer_store_b64(o, rm, vo + 32 * mf, so, 0); }
    }
#undef R2_ISSUE_KV
#undef R2_ISSUE_Q
}
typedef float cf2 __attribute__((ext_vector_type(2)));
__device__ __forceinline__ cf2 cmul(cf2 a, cf2 b) { return cf2{a.x * b.x - a.y * b.y, a.x * b.y + a.y * b.x}; }
template <int CTRL> __device__ __forceinline__ float qperm(float x) { return __int_as_float(__builtin_amdgcn_update_dpp(0, __float_as_int(x), CTRL, 0xf, 0xf, false)); }
__device__ __forceinline__ cf2 cswapneg(cf2 a) { return cf2{a.y, -a.x}; }
__device__ __forceinline__ cf2 cmulv(cf2 a, cf2 w, cf2 wr) { return __builtin_elementwise_fma(cf2{a.y, a.y}, wr, cf2{a.x, a.x} * w); }
__device__ __forceinline__ void dft4v(cf2& a0, cf2& a1, cf2& a2, cf2& a3) {
    const cf2 s02 = a0 + a2, d02 = a0 - a2, s13 = a1 + a3, d13 = a1 - a3, r = cswapneg(d13);
    a0 = s02 + s13; a2 = s02 - s13; a1 = d02 + r; a3 = d02 - r;
}
__device__ __forceinline__ void fft16v(cf2 (&v)[16]) {
#pragma unroll
    for (int m0 = 0; m0 < 4; ++m0) dft4v(v[m0], v[4 + m0], v[8 + m0], v[12 + m0]);
    constexpr float C1 = 0.92387953251128674f, S1 = 0.38268343236508977f, C2 = 0.70710678118654752f;
#define FT16(i, wc_, ws_) v[i] = cmulv(v[i], cf2{wc_, ws_}, cf2{-(ws_), wc_})
    FT16(5, C1, -S1); FT16(6, C2, -C2); FT16(7, S1, -C1);
    FT16(9, C2, -C2); v[10] = cswapneg(v[10]); FT16(11, -C2, -C2);
    FT16(13, S1, -C1); FT16(14, -C2, -C2); FT16(15, -C1, S1);
#undef FT16
#pragma unroll
    for (int q = 0; q < 4; ++q) dft4v(v[4 * q], v[4 * q + 1], v[4 * q + 2], v[4 * q + 3]);
}
struct QuadCtx { cf2 tw[16]; cf2 sg, kA, kB; };
__device__ __forceinline__ void quad_ctx(QuadCtx& Q, int n0) {
    const float n0r = (float)n0 * (1.f / 64.f);
#pragma unroll
    for (int s = 1; s < 16; ++s) { const int q = (s >> 2) + 4 * (s & 3); const float ang = n0r * (float)q; Q.tw[s] = cf2{__builtin_amdgcn_cosf(ang), -__builtin_amdgcn_sinf(ang)}; }
    const float sg = (n0 & 2) ? -1.f : 1.f; Q.sg = cf2{sg, sg};
    Q.kA = (n0 == 0) ? cf2{1.f, 1.f} : (n0 == 2) ? cf2{-1.f, -1.f} : cf2{0.f, 0.f};
    Q.kB = (n0 == 1) ? cf2{1.f, -1.f} : (n0 == 3) ? cf2{-1.f, 1.f} : cf2{0.f, 0.f};
}
template <int CTRL> __device__ __forceinline__ cf2 qperm2(cf2 v) { return cf2{qperm<CTRL>(v.x), qperm<CTRL>(v.y)}; }
__device__ __forceinline__ void fft64_quadv(cf2 (&a)[16], const QuadCtx& Q) {
    fft16v(a);
#pragma unroll
    for (int s = 1; s < 16; ++s) a[s] = cmulv(a[s], Q.tw[s], cf2{-Q.tw[s].y, Q.tw[s].x});
#pragma unroll
    for (int s = 0; s < 16; ++s) {
        const cf2 t = __builtin_elementwise_fma(a[s], Q.sg, qperm2<0x4E>(a[s]));
        const cf2 E = qperm2<0x88>(t), O = qperm2<0xDD>(t);
        a[s] = __builtin_elementwise_fma(cf2{O.y, O.x}, Q.kB, __builtin_elementwise_fma(O, Q.kA, E));
    }
}
__device__ __forceinline__ int fft_row(int l1, int l2) { return 65 * l1 + ((l2 + 2 * (l1 & 3)) & 63); }
__device__ __forceinline__ void ph_fft2(Frame& F, LAS unsigned char* L, int first, int stride) {
    const __amdgpu_buffer_rsrc_t ry = __builtin_amdgcn_make_buffer_rsrc((void*)(F.ws + WS_PROJ + PROJ_Y * 2), (short)0, (int)((size_t)M * 512 * 2), 0x00020000);
    const __amdgpu_buffer_rsrc_t rm = __builtin_amdgcn_make_buffer_rsrc((void*)(F.ws + WS_H), (short)0, (int)((size_t)M * D * 2), 0x00020000);
    LAS unsigned char* IM = L + 65 * 64 * 32;
    const int n0 = F.tid & 3, quad = F.tid >> 2, c = quad & 7, qh = quad >> 3;
    QuadCtx Q; quad_ctx(Q, n0);
#define FFT_ITEM(i0_) ((stride == 128) ? (((first & 7) + 8 * (((first >> 3) >> 3) + 2 * ((i0_) >> 7))) * 8 + ((first >> 3) & 7)) : (i0_))
    v4u w[16];
    { const int itf = FFT_ITEM((first < NB * 4 * 8) ? first : 0);
#pragma unroll
      for (int i = 0; i < 16; ++i) w[i] = __builtin_amdgcn_raw_buffer_load_b128(ry, (F.tid + 512 * i) * 16, itf * 131072, 0); }
    for (int it0 = first; it0 < NB * 4 * 8; it0 += stride) {
        const int it = FFT_ITEM(it0);
        const int cb = it & 7, bg = it >> 3, b = bg >> 2, g = bg & 3;
        __syncthreads();
#pragma unroll
        for (int i = 0; i < 16; ++i) { const int q = F.tid + 512 * i, tok = q >> 1; *(LAS v4u*)(L + fft_row(tok >> 6, tok & 63) * 32 + (q & 1) * 16) = w[i]; }
        __syncthreads();
#pragma unroll 1
        for (int ps = 0; ps < 4; ++ps) { const int l2 = 16 * ps + qh; int n0o = n0; asm volatile("" : "+v"(n0o));
            cf2 a[16];
#pragma unroll
            for (int n1 = 0; n1 < 16; ++n1) { const unsigned w = *(const LAS unsigned*)(L + fft_row(4 * n1 + n0o, l2) * 32 + c * 4); a[n1] = cf2{bflo(w), bfhi(w)}; }
            fft64_quadv(a, Q);
            const float l2r = (float)l2 * (1.f / 4096.f);
#pragma unroll
            for (int s = 0; s < 16; ++s) { const int q = (s >> 2) + 4 * (s & 3), l1p = q + 16 * n0o; const float ang = l2r * (float)l1p;
                const cf2 o = cmul(a[s], cf2{__builtin_amdgcn_cosf(ang), -__builtin_amdgcn_sinf(ang)});
                *(LAS unsigned*)(L + fft_row(l1p, l2) * 32 + c * 4) = pk2(o.x, o.y); } }
        __syncthreads();
#pragma unroll 1
        for (int ps = 0; ps < 4; ++ps) { const int l1p = 16 * ps + qh; int n0o = n0; asm volatile("" : "+v"(n0o));
            cf2 a[16];
#pragma unroll
            for (int n1 = 0; n1 < 16; ++n1) { const unsigned w = *(const LAS unsigned*)(L + fft_row(l1p, 4 * n1 + n0o) * 32 + c * 4); a[n1] = cf2{bflo(w), bfhi(w)}; }
            fft64_quadv(a, Q);
#pragma unroll
            for (int s = 0; s < 16; ++s) { const int q = (s >> 2) + 4 * (s & 3), k = q + 16 * n0o;
                *(LAS float*)(L + fft_row(l1p, k) * 32 + c * 4) = a[s].x;
                if (cb == 0 && c == 0) *(LAS unsigned short*)(IM + (l1p + 64 * k) * 2) = (unsigned short)f2bf(a[s].y); } }
        __syncthreads();
        { const int itn = FFT_ITEM((it0 + stride < NB * 4 * 8) ? it0 + stride : it0);
#pragma unroll
          for (int i = 0; i < 16; ++i) w[i] = __builtin_amdgcn_raw_buffer_load_b128(ry, (F.tid + 512 * i) * 16, itn * 131072, 0); }
        const int obase = ((b * SEQ) * D + 512 + g * 128 + 8 * cb) * 2;
#pragma unroll 2
        for (int i = 0; i < 8; ++i) { const int lp = F.tid + 512 * i, m = (SEQ - lp) & (SEQ - 1);
            const LAS unsigned char* rp_ = L + fft_row(lp & 63, lp >> 6) * 32;
            const f32x4 lo = *(const LAS f32x4*)rp_, hi = *(const LAS f32x4*)(rp_ + 16);
            float d0 = lo.x, m0 = lo.x;
            if (cb == 0) { const float rem = *(const LAS float*)(L + fft_row(m & 63, m >> 6) * 32);
                const float iml = bf2f(*(const LAS unsigned short*)(IM + lp * 2)), imm = bf2f(*(const LAS unsigned short*)(IM + m * 2));
                d0 = 0.5f * (lo.x + rem); m0 = 0.5f * (iml + imm); }
            v4u o; o.y = pk2(lo.z, lo.w); o.z = pk2(hi.x, hi.y); o.w = pk2(hi.z, hi.w);
            o.x = pk2(d0, lo.y); __builtin_amdgcn_raw_buffer_store_b128(o, rm, lp * D * 2, obase, 0);
            o.x = pk2(m0, lo.y); __builtin_amdgcn_raw_buffer_store_b128(o, rm, m * D * 2 + 128, obase, 0); }
    }
#undef FFT_ITEM
}
__device__ __forceinline__ void ph_mid(Frame& F) {
    float* vG = (float*)F.lds; float* vA = vG + D; float* vB = vA + D;
    const bf16* mo = (const bf16*)(F.ws + WS_MIXOUT); bf16* hf = (bf16*)(F.ws + WS_H);
    typedef float f32x2 __attribute__((ext_vector_type(2)));
    const f32x2* tm = (const f32x2*)(F.ws + WS_TM);
    f32x2 pre[3];
#pragma unroll
    for (int k = 0; k < 3; ++k) pre[k] = tm[k * (D / 2) + F.tid];
#define MID_TABLE() do { __syncthreads(); _Pragma("unroll") for (int k = 0; k < 3; ++k) ((f32x2*)vG)[k * (D / 2) + F.tid] = pre[k]; __syncthreads(); \
        if (b + 1 < NB) { _Pragma("unroll") for (int k = 0; k < 3; ++k) pre[k] = tm[(size_t)(b + 1) * 3 * (D / 2) + k * (D / 2) + F.tid]; } } while (0)
    for (int b = 0; b < NB; ++b) {
        bool staged = false;
        for (int rb = blockIdx.x; rb < SEQ / 16; rb += F.G) {
            const size_t row0 = (size_t)b * SEQ + (size_t)rb * 16 + 2 * F.wave;
            f32x4 v[2][4], xv[2][4]; float ss[2]; v2u mw[2][4];
#pragma unroll
            for (int q = 0; q < 2; ++q) { const size_t row = row0 + q;
                const v2u* mr4 = (const v2u*)(mo + row * D) + F.lane; const f32x4* xr = (const f32x4*)(F.x + row * D) + F.lane;
#pragma unroll
                for (int j = 0; j < 4; ++j) { mw[q][j] = mr4[64 * j]; xv[q][j] = xr[64 * j]; } }
            if (!staged) { MID_TABLE(); staged = true; }
#pragma unroll
            for (int q = 0; q < 2; ++q)
#pragma unroll
                for (int j = 0; j < 4; ++j) { const v2u w = mw[q][j]; v[q][j] = (f32x4){bflo(w.x), bfhi(w.x), bflo(w.y), bfhi(w.y)}; }
#pragma unroll
            for (int q = 0; q < 2; ++q) { ss[q] = 0.f;
#pragma unroll
                for (int j = 0; j < 4; ++j) ss[q] += (v[q][j].x * v[q][j].x + v[q][j].y * v[q][j].y) + (v[q][j].z * v[q][j].z + v[q][j].w * v[q][j].w); }
#pragma unroll
            for (int q = 0; q < 2; ++q) { const float rstd = rsqrtf(wave_sum(ss[q]) * (1.f / D) + NORM_EPS); float s1 = 0.f;
#pragma unroll
                for (int j = 0; j < 4; ++j) { const int c0 = 4 * F.lane + 256 * j; const f32x4 g = *(const f32x4*)(vG + c0);
                    v[q][j] = xv[q][j] + v[q][j] * rstd * g; s1 += (v[q][j].x * v[q][j].x + v[q][j].y * v[q][j].y) + (v[q][j].z * v[q][j].z + v[q][j].w * v[q][j].w); }
                ss[q] = s1; }
#pragma unroll
            for (int q = 0; q < 2; ++q) { const float rstd1 = rsqrtf(wave_sum(ss[q]) * (1.f / D) + NORM_EPS); const size_t row = row0 + q;
                unsigned long long* o8 = (unsigned long long*)(hf + row * D) + F.lane; unsigned long long* x8 = (unsigned long long*)((bf16*)(F.ws + WS_X1B) + row * D) + F.lane;
#pragma unroll
                for (int j = 0; j < 4; ++j) { const int c0 = 4 * F.lane + 256 * j; const f32x4 a = *(const f32x4*)(vA + c0), bb = *(const f32x4*)(vB + c0);
                    const f32x4 h = v[q][j] * rstd1 * a + bb;
                    x8[64 * j] = (unsigned long long)pk2(v[q][j].x, v[q][j].y) | ((unsigned long long)pk2(v[q][j].z, v[q][j].w) << 32);
                    o8[64 * j] = (unsigned long long)pk2(h.x, h.y) | ((unsigned long long)pk2(h.z, h.w) << 32); } }
        }
        if (!staged) MID_TABLE();
    }
#undef MID_TABLE
}
__device__ __forceinline__ void ph_gate_table(Frame& F) {
    if ((int)blockIdx.x < 64 && F.tid < 256) { const int b = (int)blockIdx.x >> 2, col = 256 * ((int)blockIdx.x & 3) + F.tid;
        ((float*)(F.ws + WS_TG2))[b * D + col] = F.g_ffn_post[col] * mod_val(F, b, 5, col);
        float* tm = (float*)(F.ws + WS_TM) + (size_t)b * 3 * D;
        tm[col] = F.g_mix_post[col] * mod_val(F, b, 2, col); tm[D + col] = F.g_ffn_pre[col] * (1.f + mod_val(F, b, 4, col)); tm[2 * D + col] = mod_val(F, b, 3, col); }
    if ((int)blockIdx.x >= 64 && (int)blockIdx.x < 64 + 44) { const int idx = ((int)blockIdx.x - 64) * NTHR + F.tid, vec = idx / NUP, col = idx - vec * NUP;
        const float v_ = (vec < 3) ? F.conv_w[vec * NUP + col] : F.conv_b[col];
        ((float*)(F.ws + WS_CONVT))[idx] = v_ * ((col < DFF) ? -1.4426950408889634f : -0.6931471805599453f); }
}
__device__ __forceinline__ void ph_final(Frame& F) {
    float* vG2 = (float*)F.lds; const bf16* ff = (const bf16*)(F.ws + WS_FFN); const bf16* x1b = (const bf16*)(F.ws + WS_X1B);
    __syncthreads();
    bool staged = false;
#define FIN_TABLE() do { const f32x4* tg = (const f32x4*)(F.ws + WS_TG2); f32x4 t_[NB * D / 4 / NTHR]; \
        _Pragma("unroll") for (int i = 0; i < NB * D / 4 / NTHR; ++i) t_[i] = tg[F.tid + NTHR * i]; \
        _Pragma("unroll") for (int i = 0; i < NB * D / 4 / NTHR; ++i) ((f32x4*)vG2)[F.tid + NTHR * i] = t_[i]; \
        __syncthreads(); } while (0)
    for (int b = 0; b < NB; ++b)
    for (int rb = blockIdx.x; rb < SEQ / 16; rb += F.G) {
        const size_t row0 = (size_t)b * SEQ + (size_t)rb * 16 + 2 * F.wave;
        f32x4 v[2][4], xv[2][4]; float ss[2]; v2u rf[2][4], rx[2][4];
#pragma unroll
        for (int q = 0; q < 2; ++q) { const size_t row = row0 + q;
            const v2u* fr4 = (const v2u*)(ff + row * D) + F.lane; const v2u* xr = (const v2u*)(x1b + row * D) + F.lane;
#pragma unroll
            for (int j = 0; j < 4; ++j) { rf[q][j] = fr4[64 * j]; rx[q][j] = xr[64 * j]; } }
        if (!staged) { FIN_TABLE(); staged = true; }
#pragma unroll
        for (int q = 0; q < 2; ++q)
#pragma unroll
            for (int j = 0; j < 4; ++j) { const v2u w = rf[q][j]; v[q][j] = (f32x4){bflo(w.x), bfhi(w.x), bflo(w.y), bfhi(w.y)};
                const v2u w2 = rx[q][j]; xv[q][j] = (f32x4){bflo(w2.x), bfhi(w2.x), bflo(w2.y), bfhi(w2.y)}; }
#pragma unroll
        for (int q = 0; q < 2; ++q) { ss[q] = 0.f;
#pragma unroll
            for (int j = 0; j < 4; ++j) ss[q] += (v[q][j].x * v[q][j].x + v[q][j].y * v[q][j].y) + (v[q][j].z * v[q][j].z + v[q][j].w * v[q][j].w); }
#pragma unroll
        for (int q = 0; q < 2; ++q) { const float rstd = rsqrtf(wave_sum(ss[q]) * (1.f / D) + NORM_EPS);
            f32x4* orow = (f32x4*)(F.out + (row0 + q) * D) + F.lane;
#pragma unroll
            for (int j = 0; j < 4; ++j) { const int c0 = 4 * F.lane + 256 * j; const f32x4 g2 = *(const f32x4*)(vG2 + b * D + c0);
                orow[64 * j] = xv[q][j] + v[q][j] * rstd * g2; } }
    }
    if (!staged) FIN_TABLE();
#undef FIN_TABLE
}
#define XB_TMO      128
#define XB_XCNT(j)  (256  + 64 * (j))
#define XB_XSUB(j)  (1280 + 64 * (j))
#define XB_TOP      3328
#define XCD_BAR_WORDS 3456
#define XB_SPIN_CAP (1u << 18)

__device__ __forceinline__ unsigned xb_ld(unsigned* p)              { return __hip_atomic_load(p, __ATOMIC_RELAXED, __HIP_MEMORY_SCOPE_AGENT); }
__device__ __forceinline__ unsigned xb_add(unsigned* p, unsigned v) { return __hip_atomic_fetch_add(p, v, __ATOMIC_RELAXED, __HIP_MEMORY_SCOPE_AGENT); }
__device__ __forceinline__ unsigned xb_xcc_id() { return (unsigned)__builtin_amdgcn_s_getreg((3 << 11) | 20) & 0xFu; }
#define XB_SPIN(cond, bar) do { unsigned _sp = 0; while (cond) { __builtin_amdgcn_s_sleep(1); \
    if ((++_sp & 255u) == 0u) { if (xb_ld(&(bar)[XB_TMO])) break; if (_sp > XB_SPIN_CAP) { atomicAdd(&(bar)[XB_TMO], 1u); break; } } } } while (0)

struct XcdBarrier {
    unsigned* bar; unsigned x;
    volatile LAS unsigned* st;
};

__device__ __forceinline__ XcdBarrier xcd_barrier_post(unsigned* bar, volatile LAS unsigned* st) {
    XcdBarrier b; b.bar = bar; b.x = xb_xcc_id(); b.st = st;
    if (threadIdx.x == 0) (void)xb_add(&bar[XB_XCNT(b.x)], 1u);
    return b;
}
__device__ __forceinline__ void xcd_barrier_complete(unsigned* bar, unsigned x, unsigned& nloc, unsigned& nx) {
    const unsigned G = gridDim.x * gridDim.y * gridDim.z;
    unsigned sum, cnt, mine, sp = 0u;
    for (;;) {
        sum = 0u; cnt = 0u; mine = 0u;
#pragma unroll
        for (unsigned j = 0; j < 16; ++j) { const unsigned c = xb_ld(&bar[XB_XCNT(j)]); sum += c; cnt += (c > 0u) ? 1u : 0u; mine = (j == x) ? c : mine; }
        if (sum == G) break;
        __builtin_amdgcn_s_sleep(1);
        if ((++sp & 255u) == 0u) { if (xb_ld(&bar[XB_TMO])) break; if (sp > XB_SPIN_CAP) { atomicAdd(&bar[XB_TMO], 1u); break; } }
    }
    nloc = mine > 0u ? mine : 1u; nx = cnt > 0u ? cnt : 1u;
}

__device__ __forceinline__ void xcd_barrier(const XcdBarrier& b) {
    asm volatile("s_waitcnt vmcnt(0)" ::: "memory");
    __syncthreads();
    if (threadIdx.x == 0) {
        unsigned* bar = b.bar;
        __builtin_amdgcn_s_waitcnt(0);
        unsigned nloc = b.st[0], nx = b.st[1];
        if (nloc == 0u) { xcd_barrier_complete(bar, b.x, nloc, nx); b.st[0] = nloc; b.st[1] = nx; }
        const unsigned old = xb_add(&bar[XB_XSUB(b.x)], 1u);
        const unsigned gen = old / nloc;
        if (old + 1u == (gen + 1u) * nloc) {
            __builtin_amdgcn_fence(__ATOMIC_RELEASE, "agent");
            asm volatile("s_waitcnt vmcnt(0)" ::: "memory");
            const unsigned og = xb_add(&bar[XB_TOP], 1u);
            if (og + 1u != (gen + 1u) * nx) XB_SPIN(xb_ld(&bar[XB_TOP]) < (gen + 1u) * nx, bar);
            __builtin_amdgcn_fence(__ATOMIC_ACQUIRE, "agent");
            asm volatile("s_waitcnt vmcnt(0)" ::: "memory");
        } else {
            XB_SPIN(xb_ld(&bar[XB_TOP]) < (gen + 1u) * nx, bar);
            __builtin_amdgcn_fence(__ATOMIC_ACQUIRE, "agent");
            asm volatile("s_waitcnt vmcnt(0)" ::: "memory");
        }
    }
    __syncthreads();
}

constexpr int CW_BAR = 4096;
constexpr int LDS_BARST = LDS_BYTES - 256;
enum { PH_PREP = 0, PH_NORM1, PH_G1, PH_RSTATE, PH_ROUT, PH_G2, PH_MID, PH_G3, PH_G4, PH_FINAL, PH_COUNT };

__global__ void __launch_bounds__(NTHR, 2) mega(Args args) {
    extern __shared__ __attribute__((aligned(16))) unsigned char lds[];
    Frame F;
    F.lds = lds; F.tid = threadIdx.x; F.lane = F.tid & 63; F.wave = __builtin_amdgcn_readfirstlane(F.tid >> 6);
    F.G = gridDim.x; { const int bx = blockIdx.x; F.vcu = (F.G % 8 == 0) ? (bx % 8) * (F.G / 8) + bx / 8 : bx; }
    F.x = args.in[0]; F.c = args.in[1]; F.ctx = args.in[2]; F.c_ctx = args.in[3]; F.w_ada = args.in[4]; F.b_ada = args.in[5];
    F.g_mix_pre = args.in[6]; F.g_mix_post = args.in[7]; F.g_ffn_pre = args.in[8]; F.g_ffn_post = args.in[9]; F.w_in = args.in[10];
    F.dec_f = args.in[11]; F.dec_b = args.in[12]; F.w_out = args.in[13]; F.w_up = args.in[14]; F.conv_w = args.in[15]; F.conv_b = args.in[16]; F.w_down = args.in[17];
    F.out = args.out; F.ws = args.ws;
    PG8_LAS unsigned char* ldsl = (PG8_LAS unsigned char*)lds;
    const int lo = args.ph_lo, hi = args.ph_hi;
#define IN(k) (lo <= (k) && (k) < hi)
#define REFRESH() do { int t_ = threadIdx.x; asm volatile("" : "+v"(t_)); F.tid = t_; F.lane = t_ & 63; } while (0)
    volatile LAS unsigned* barst = (volatile LAS unsigned*)((LAS unsigned char*)ldsl + LDS_BARST);
    if (threadIdx.x < 2) barst[threadIdx.x] = 0u;
    __syncthreads();
    const XcdBarrier xbar = xcd_barrier_post((unsigned*)(args.ws + WS_CTL) + CW_BAR, barst);
    if (lo < 0) cg::this_grid().sync();
#define SEAM(k) do { if (IN(k) && IN((k) + 1)) xcd_barrier(xbar); } while (0)
    if (IN(PH_PREP)) { REFRESH(); ph_prep_ada(F); }
    SEAM(PH_PREP);
    if (IN(PH_NORM1)) { REFRESH(); ph_gate_table(F); if (blockIdx.x & 1) { REFRESH(); ph_prep_w(F); REFRESH(); ph_norm1(F); } else { REFRESH(); ph_norm1(F); REFRESH(); ph_prep_w(F); } }
    SEAM(PH_NORM1);
    if (IN(PH_G1)) {
        { pg8::Gemm g{(const bf16*)(F.ws + WS_H), (const bf16*)(F.ws + WS_WIN), M, INW, D}; pg8::StaticOrder S; S.init(M, INW, F.G, (int)blockIdx.x, WGM_G1);
          pg8::EpiInProj E{(bf16*)(F.ws + WS_PROJ), 0}; pg8::gemm_phase<pg8::EpiInProj, pg8::StaticOrder, true, true>(ldsl, g, S, E); }
        { pg8::Gemm g{(const bf16*)(F.ws + WS_HCTX), (const bf16*)(F.ws + WS_WIN) + (size_t)RETW * D, MCTX, 2 * RETW, D}; pg8::StaticOrder S; S.init(MCTX, 2 * RETW, F.G, (int)blockIdx.x, WGM_G1);
          pg8::EpiInProj E{(bf16*)(F.ws + WS_CKV), 1}; pg8::gemm_phase<pg8::EpiInProj, pg8::StaticOrder, true, true>(ldsl, g, S, E); }
        if (F.G > 64) { if ((int)blockIdx.x >= 64) { REFRESH(); ph_prep_wrest(F, ((int)blockIdx.x - 64) * NWAVES + F.wave, (F.G - 64) * NWAVES); } }
        else { REFRESH(); ph_prep_wrest(F, (int)blockIdx.x * NWAVES + F.wave, F.G * NWAVES); }
    }
    SEAM(PH_G1);
    if (IN(PH_RSTATE)) { const int half_id = (int)(((blockIdx.x >> 4) << 3) | (blockIdx.x & 7));
        if (F.G != 256) { REFRESH(); for (int ch = blockIdx.x; ch < 128; ch += F.G) ph_ret_states(F, (LAS unsigned char*)ldsl, ch); REFRESH(); ph_fft2(F, (LAS unsigned char*)ldsl, (int)blockIdx.x, F.G); }
        else if (((blockIdx.x >> 3) & 1) == 0) { REFRESH(); ph_ret_states_rs(F, (LAS unsigned char*)ldsl, half_id); }
        else { REFRESH(); ph_fft2(F, (LAS unsigned char*)ldsl, half_id, 128); } }
    SEAM(PH_RSTATE);
    if (IN(PH_ROUT)) { REFRESH(); ph_ret_out(F, (LAS unsigned char*)ldsl); }
    SEAM(PH_ROUT);
    if (IN(PH_G2)) { pg8::Gemm g{(const bf16*)(F.ws + WS_H), (const bf16*)(F.ws + WS_WOUT), M, D, D}; pg8::StaticOrder S; S.init(M, D, F.G, (int)blockIdx.x, WGM_G2);
        pg8::EpiBf16 E{(bf16*)(F.ws + WS_MIXOUT), D}; pg8::gemm_phase<pg8::EpiBf16, pg8::StaticOrder, true, true>(ldsl, g, S, E); }
    SEAM(PH_G2);
    if (IN(PH_MID)) { REFRESH(); ph_mid(F); }
    SEAM(PH_MID);
    if (IN(PH_G3)) { pg8::Gemm g{(const bf16*)(F.ws + WS_H), (const bf16*)(F.ws + WS_WUP), M, NUP, D}; pg8::StaticOrder S; S.init(M, NUP, F.G, (int)blockIdx.x, WGM_G3);
        pg8::EpiUp E{(bf16*)(F.ws + WS_ACT), (const float*)(F.ws + WS_CONVT)}; pg8::gemm_phase<pg8::EpiUp, pg8::StaticOrder, true, true>(ldsl, g, S, E); }
    SEAM(PH_G3);
    if (IN(PH_G4)) { pg8::Gemm g{(const bf16*)(F.ws + WS_ACT), (const bf16*)(F.ws + WS_WDN), M, D, DFF}; pg8::StaticOrder S; S.init(M, D, F.G, (int)blockIdx.x, WGM_G4);
        pg8::EpiBf16 E{(bf16*)(F.ws + WS_FFN), D}; pg8::gemm_phase<pg8::EpiBf16, pg8::StaticOrder, true, true>(ldsl, g, S, E); }
    SEAM(PH_G4);
    if (IN(PH_FINAL)) { REFRESH(); ph_final(F); }
#undef IN
}

extern "C" void kernel_launch(void* const* d_in, const int* in_sizes, int n_in, void* d_out, int out_size, void* d_ws, size_t ws_size, hipStream_t stream) {
    static int grid = 0;
    if (grid == 0) {
        if (n_in != 18 || out_size != M * D || ws_size < WS_END) { fprintf(stderr, "kernel_launch: unexpected shapes n_in %d out %d ws %zu\n", n_in, out_size, ws_size); grid = -1; return; }
        int dev = 0, cus = 0;
        if (hipGetDevice(&dev) != hipSuccess || hipDeviceGetAttribute(&cus, hipDeviceAttributeMultiprocessorCount, dev) != hipSuccess) { grid = -1; return; }
        if (hipFuncSetAttribute((const void*)mega, hipFuncAttributeMaxDynamicSharedMemorySize, LDS_BYTES) != hipSuccess) { fprintf(stderr, "hipFuncSetAttribute failed\n"); grid = -1; return; }
        int per_cu = 0;
        if (hipOccupancyMaxActiveBlocksPerMultiprocessor(&per_cu, (const void*)mega, NTHR, LDS_BYTES) != hipSuccess || per_cu < 1) { fprintf(stderr, "occupancy query: %d\n", per_cu); grid = -1; return; }
        grid = cus * per_cu;
    }
    if (grid < 0) return;
    if (hipMemsetAsync((char*)d_ws + WS_CTL, 0, 65536, stream) != hipSuccess) { fprintf(stderr, "memset failed\n"); return; }
    Args a{};
    for (int i = 0; i < 18; ++i) a.in[i] = (const float*)d_in[i];
    a.out = (float*)d_out; a.ws = (unsigned char*)d_ws;
#if MK_ONE_LAUNCH
    a.ph_lo = 0; a.ph_hi = PH_COUNT;
    void* kargs[] = {&a};
    hipError_t e = hipLaunchCooperativeKernel((const void*)mega, dim3(grid), dim3(NTHR), kargs, LDS_BYTES, stream);
    if (e != hipSuccess) fprintf(stderr, "cooperative launch failed: %s (grid %d)\n", hipGetErrorString(e), grid);
#else
    for (int ph = 0; ph < PH_COUNT; ++ph) { a.ph_lo = ph; a.ph_hi = ph + 1; hipLaunchKernelGGL(mega, dim3(grid), dim3(NTHR), LDS_BYTES, stream, a); }
#endif
}
```
